# Optimizing an MI355X kernel written in HIP

```python
import math
import jax, jax.numpy as jnp
from jax import lax
import numpy as np

D_MODEL = 1024
BATCH = 8
SEQ = 4096
DEPTH = 2

PLE_DIM = 256
ROPE_THETA = 10000.0
NORM_EPS = 1e-6
Q_BLOCK = 128

RET_WIDTH = D_MODEL // 2
RET_HEADS = 8
RET_HEAD_DIM = RET_WIDTH // RET_HEADS
RET_CHUNK = 128
S5_WIDTH = D_MODEL - RET_WIDTH
S5_GROUP = 16
S5_GROUPS = S5_WIDTH // S5_GROUP
S5_STATE = 64
EVEN_IN_WIDTH = 4 * RET_WIDTH + S5_WIDTH
MIX_WIDTH = RET_WIDTH + S5_WIDTH

DIFF_HEADS = 8
DIFF_QK_DIM = 64
DIFF_V_DIM = 2 * DIFF_QK_DIM
DIFF_QK_WIDTH = DIFF_HEADS * 2 * DIFF_QK_DIM
DIFF_WIDTH = DIFF_HEADS * DIFF_V_DIM
DIFF_IN_WIDTH = 2 * DIFF_QK_WIDTH + DIFF_WIDTH

FFN_HIDDEN = -(-8 * D_MODEL // (3 * 256)) * 256

N_EVEN = (DEPTH + 1) // 2
N_ODD = DEPTH // 2

kernel_name = "hybrid_retention_s5_diffattn_block"


def rms_norm(x, gain):
    xf = x.astype(jnp.float32)
    y = xf * lax.rsqrt(jnp.mean(xf * xf, axis=-1, keepdims=True) + NORM_EPS)
    return (y * gain.astype(jnp.float32)).astype(x.dtype)


def head_layer_norm(x):
    mu = jnp.mean(x, axis=-1, keepdims=True)
    xc = x - mu
    return xc * lax.rsqrt(jnp.mean(xc * xc, axis=-1, keepdims=True) + NORM_EPS)


def rotary(x, pos):
    d = x.shape[-1]
    inv = ROPE_THETA ** (-jnp.arange(0, d, 2, dtype=jnp.float32) / d)
    ang = pos.astype(jnp.float32)[:, None] * inv[None, :]
    cos = jnp.concatenate([jnp.cos(ang), jnp.cos(ang)], axis=-1)
    sin = jnp.concatenate([jnp.sin(ang), jnp.sin(ang)], axis=-1)
    xf = x.astype(jnp.float32)
    x1, x2 = xf[..., : d // 2], xf[..., d // 2:]
    rot = jnp.concatenate([-x2, x1], axis=-1)
    return (xf * cos + rot * sin).astype(x.dtype)


def retention(q, k, v):
    bsz, n_h, s_len, d = q.shape
    c = RET_CHUNK
    n_chunks = s_len // c
    gamma = 1.0 - 2.0 ** (-5.0 - jnp.arange(n_h, dtype=jnp.float32))
    log_g = jnp.log(gamma)
    idx = jnp.arange(c, dtype=jnp.float32)
    rel = idx[:, None] - idx[None, :]
    intra_decay = jnp.where(rel >= 0, jnp.exp(log_g[:, None, None] * jnp.maximum(rel, 0.0)), 0.0)
    k_decay = jnp.exp(log_g[:, None] * (c - 1 - idx))
    q_decay = jnp.exp(log_g[:, None] * (idx + 1.0))
    chunk_decay = jnp.exp(log_g * c)
    qf = q.astype(jnp.float32).reshape(bsz, n_h, n_chunks, c, d)
    kf = k.astype(jnp.float32).reshape(bsz, n_h, n_chunks, c, d) * (d ** -0.5)
    vf = v.astype(jnp.float32).reshape(bsz, n_h, n_chunks, c, d)
    scores = jnp.einsum('bhncd,bhnsd->bhncs', qf, kf) * intra_decay[:, None]
    intra = jnp.einsum('bhncs,bhnse->bhnce', scores, vf)
    kv = jnp.einsum('bhnsd,bhnse->nbhde', kf * k_decay[:, None, :, None], vf)

    def step(r_state, kv_n):
        return chunk_decay[:, None, None] * r_state + kv_n, r_state

    _, r_prev = lax.scan(step, jnp.zeros_like(kv[0]), kv)
    inter = jnp.einsum('bhncd,nbhde->bhnce', qf * q_decay[:, None, :, None], r_prev)
    return (intra + inter).reshape(bsz, n_h, s_len, d)


def s5_mixer(u, lam_re, lam_im, b_re, b_im, c_re, c_im, d_skip, log_step, w_glu):
    bsz, s_len, _ = u.shape
    f32 = jnp.float32
    uf = u.astype(f32).reshape(bsz, s_len, S5_GROUPS, S5_GROUP)
    lam = lax.complex(lam_re.astype(f32), lam_im.astype(f32))
    delta = jnp.exp(log_step.astype(f32))[:, None]
    lam_bar = jnp.exp(lam * delta)
    b_mat = lax.complex(b_re.astype(f32), b_im.astype(f32))
    b_bar = ((lam_bar - 1.0) / lam)[:, :, None] * b_mat
    bu = jnp.einsum('gpc,bsgc->bsgp', b_bar, uf.astype(jnp.complex64))
    a = jnp.broadcast_to(lam_bar, bu.shape)

    def combine(e1, e2):
        a1, x1 = e1
        a2, x2 = e2
        return a2 * a1, a2 * x1 + x2

    _, states = lax.associative_scan(combine, (a, bu), axis=1)
    c_mat = lax.complex(c_re.astype(f32), c_im.astype(f32))
    y = jnp.einsum('gcp,bsgp->bsgc', c_mat, states).real + d_skip.astype(f32) * uf
    y = jax.nn.gelu(y.reshape(bsz, s_len, S5_WIDTH))
    y = y * jax.nn.sigmoid(y @ w_glu.astype(f32))
    return y.astype(u.dtype)


def even_mixer(h, pos, w_in, w_out, lam_re, lam_im, b_re, b_im, c_re, c_im, d_skip, log_step, w_glu):
    bsz, s_len, _ = h.shape
    proj = h @ w_in
    q, k, v, g, u = jnp.split(proj, [RET_WIDTH, 2 * RET_WIDTH, 3 * RET_WIDTH, 4 * RET_WIDTH], axis=-1)

    def heads(t):
        return t.reshape(bsz, s_len, RET_HEADS, RET_HEAD_DIM).transpose(0, 2, 1, 3)

    ret = retention(rotary(heads(q), pos), rotary(heads(k), pos), heads(v))
    ret = head_layer_norm(ret).transpose(0, 2, 1, 3).reshape(bsz, s_len, RET_WIDTH)
    ret = (jax.nn.silu(g.astype(jnp.float32)) * ret).astype(h.dtype)
    ssm = s5_mixer(u, lam_re, lam_im, b_re, b_im, c_re, c_im, d_skip, log_step, w_glu)
    return jnp.concatenate([ret, ssm], axis=-1) @ w_out


def diff_attention(h, pos, w_qkv, w_o, lq1, lk1, lq2, lk2, subln, lambda_init):
    bsz, s_len, _ = h.shape
    f32 = jnp.float32
    proj = h @ w_qkv
    q, k, v = jnp.split(proj, [DIFF_QK_WIDTH, 2 * DIFF_QK_WIDTH], axis=-1)
    q = rotary(q.reshape(bsz, s_len, 2 * DIFF_HEADS, DIFF_QK_DIM).transpose(0, 2, 1, 3), pos)
    k = rotary(k.reshape(bsz, s_len, 2 * DIFF_HEADS, DIFF_QK_DIM).transpose(0, 2, 1, 3), pos)
    vf = v.reshape(bsz, s_len, DIFF_HEADS, DIFF_V_DIM).transpose(0, 2, 1, 3).astype(f32)
    kf = k.astype(f32)
    lam = (jnp.exp(jnp.sum(lq1.astype(f32) * lk1.astype(f32)))
           - jnp.exp(jnp.sum(lq2.astype(f32) * lk2.astype(f32))) + lambda_init)
    scale = DIFF_QK_DIM ** -0.5
    n_blocks = s_len // Q_BLOCK
    q_blocks = q.reshape(bsz, 2 * DIFF_HEADS, n_blocks, Q_BLOCK, DIFF_QK_DIM).transpose(2, 0, 1, 3, 4)
    qpos_blocks = pos.reshape(n_blocks, Q_BLOCK)

    def block(args):
        qblk, qpos = args
        s = jnp.einsum('bhqd,bhkd->bhqk', qblk.astype(f32), kf) * scale
        s = jnp.where(pos[None, :] <= qpos[:, None], s, -jnp.inf)
        att = jax.nn.softmax(s, axis=-1).reshape(bsz, DIFF_HEADS, 2, Q_BLOCK, s_len)
        w = att[:, :, 0] - lam * att[:, :, 1]
        return jnp.einsum('bhqk,bhkd->bhqd', w, vf)

    out = lax.map(block, (q_blocks, qpos_blocks))
    out = out.transpose(1, 2, 0, 3, 4).reshape(bsz, DIFF_HEADS, s_len, DIFF_V_DIM)
    out = rms_norm(out, subln) * (1.0 - lambda_init)
    out = out.transpose(0, 2, 1, 3).reshape(bsz, s_len, DIFF_WIDTH).astype(h.dtype)
    return out @ w_o


def swiglu(h, w_gate, w_up, w_down):
    return (jax.nn.silu(h @ w_gate) * (h @ w_up)) @ w_down


def setup_inputs(seed: int = 0) -> dict:
    key = jax.random.key(seed)
    ks = jax.random.split(key, 32)
    nrm = jax.random.normal
    f32 = jnp.float32
    inp = {}
    inp['x'] = nrm(ks[0], (BATCH, SEQ, D_MODEL), f32)
    inp['p'] = nrm(ks[1], (DEPTH, BATCH, SEQ, PLE_DIM), f32)
    inp['norm_mix'] = 1.0 + 0.02 * nrm(ks[2], (DEPTH, D_MODEL), f32)
    inp['norm_ffn'] = 1.0 + 0.02 * nrm(ks[3], (DEPTH, D_MODEL), f32)
    inp['norm_ple'] = 1.0 + 0.02 * nrm(ks[4], (DEPTH, D_MODEL), f32)
    inp['ret_s5_w_in'] = nrm(ks[5], (N_EVEN, D_MODEL, EVEN_IN_WIDTH), f32) * D_MODEL ** -0.5
    inp['ret_s5_w_out'] = nrm(ks[6], (N_EVEN, MIX_WIDTH, D_MODEL), f32) * MIX_WIDTH ** -0.5
    inp['s5_lambda_re'] = -0.5 + 0.01 * nrm(ks[7], (N_EVEN, S5_GROUPS, S5_STATE), f32)
    inp['s5_lambda_im'] = (math.pi * jnp.arange(S5_STATE, dtype=f32)
                           + 0.01 * nrm(ks[8], (N_EVEN, S5_GROUPS, S5_STATE), f32))
    inp['s5_b_re'] = nrm(ks[9], (N_EVEN, S5_GROUPS, S5_STATE, S5_GROUP), f32) * (2 * S5_GROUP) ** -0.5
    inp['s5_b_im'] = nrm(ks[10], (N_EVEN, S5_GROUPS, S5_STATE, S5_GROUP), f32) * (2 * S5_GROUP) ** -0.5
    inp['s5_c_re'] = nrm(ks[11], (N_EVEN, S5_GROUPS, S5_GROUP, S5_STATE), f32) * S5_STATE ** -0.5
    inp['s5_c_im'] = nrm(ks[12], (N_EVEN, S5_GROUPS, S5_GROUP, S5_STATE), f32) * S5_STATE ** -0.5
    inp['s5_d'] = nrm(ks[13], (N_EVEN, S5_GROUPS, S5_GROUP), f32)
    inp['s5_log_step'] = jax.random.uniform(ks[14], (N_EVEN, S5_GROUPS), f32,
                                            minval=math.log(1e-3), maxval=math.log(1e-1))
    inp['s5_w_glu'] = nrm(ks[15], (N_EVEN, S5_WIDTH, S5_WIDTH), f32) * S5_WIDTH ** -0.5
    inp['diff_w_qkv'] = nrm(ks[16], (N_ODD, D_MODEL, DIFF_IN_WIDTH), f32) * D_MODEL ** -0.5
    inp['diff_w_o'] = nrm(ks[17], (N_ODD, DIFF_WIDTH, D_MODEL), f32) * DIFF_WIDTH ** -0.5
    inp['diff_lambda_q1'] = 0.1 * nrm(ks[18], (N_ODD, DIFF_QK_DIM), f32)
    inp['diff_lambda_k1'] = 0.1 * nrm(ks[19], (N_ODD, DIFF_QK_DIM), f32)
    inp['diff_lambda_q2'] = 0.1 * nrm(ks[20], (N_ODD, DIFF_QK_DIM), f32)
    inp['diff_lambda_k2'] = 0.1 * nrm(ks[21], (N_ODD, DIFF_QK_DIM), f32)
    inp['diff_subln'] = 1.0 + 0.02 * nrm(ks[22], (N_ODD, DIFF_V_DIM), f32)
    inp['ffn_w_gate'] = nrm(ks[23], (DEPTH, D_MODEL, FFN_HIDDEN), f32) * D_MODEL ** -0.5
    inp['ffn_w_up'] = nrm(ks[24], (DEPTH, D_MODEL, FFN_HIDDEN), f32) * D_MODEL ** -0.5
    inp['ffn_w_down'] = nrm(ks[25], (DEPTH, FFN_HIDDEN, D_MODEL), f32) * FFN_HIDDEN ** -0.5
    inp['ple_w_proj'] = nrm(ks[26], (DEPTH, PLE_DIM, D_MODEL), f32) * PLE_DIM ** -0.5
    inp['ple_w_gate'] = nrm(ks[27], (DEPTH, D_MODEL, D_MODEL), f32) * D_MODEL ** -0.5
    inp['final_norm'] = 1.0 + 0.02 * nrm(ks[28], (D_MODEL,), f32)
    return inp


def reference(x, p, norm_mix, norm_ffn, norm_ple, ret_s5_w_in, ret_s5_w_out,
              s5_lambda_re, s5_lambda_im, s5_b_re, s5_b_im, s5_c_re, s5_c_im, s5_d,
              s5_log_step, s5_w_glu, diff_w_qkv, diff_w_o, diff_lambda_q1, diff_lambda_k1,
              diff_lambda_q2, diff_lambda_k2, diff_subln, ffn_w_gate, ffn_w_up, ffn_w_down,
              ple_w_proj, ple_w_gate, final_norm):
    pos = jnp.arange(x.shape[1], dtype=jnp.int32)
    h = x
    for i in range(DEPTH):
        hn = rms_norm(h, norm_mix[i])
        j = i // 2
        if i % 2 == 0:
            mix = even_mixer(hn, pos, ret_s5_w_in[j], ret_s5_w_out[j],
                             s5_lambda_re[j], s5_lambda_im[j], s5_b_re[j], s5_b_im[j],
                             s5_c_re[j], s5_c_im[j], s5_d[j], s5_log_step[j], s5_w_glu[j])
        else:
            lambda_init = 0.8 - 0.6 * math.exp(-0.3 * i)
            mix = diff_attention(hn, pos, diff_w_qkv[j], diff_w_o[j],
                                 diff_lambda_q1[j], diff_lambda_k1[j],
                                 diff_lambda_q2[j], diff_lambda_k2[j], diff_subln[j], lambda_init)
        h = h + mix
        h = h + swiglu(rms_norm(h, norm_ffn[i]), ffn_w_gate[i], ffn_w_up[i], ffn_w_down[i])
        gate = jax.nn.sigmoid(rms_norm(h, norm_ple[i]) @ ple_w_gate[i])
        h = h + (p[i] @ ple_w_proj[i]) * gate
    return rms_norm(h, final_norm)
```

```cpp
#include <hip/hip_runtime.h>
#include <cstdio>
#include <cstdint>
#include <hip/hip_cooperative_groups.h>
namespace pg8 {
#define PG8_LAS __attribute__((address_space(3)))
typedef unsigned short bf16_t;
typedef short bf16x8 __attribute__((ext_vector_type(8)));
typedef float f32x4 __attribute__((ext_vector_type(4)));
typedef unsigned u32x4 __attribute__((ext_vector_type(4)));
constexpr int BM = 256, BK = 64, HALF = 128, HTB = HALF * BK * 2  , STAGE_BYTES = 8 * HTB, NXCD = 8, WGM = 8;

__host__ __device__ __forceinline__ int lds_byte(int r, int c) { const int st = (r >> 4) * 2 + (c >> 5), rr = r & 15, cc = c & 31, ob = rr * 64 + cc * 2; return st * 1024 + (ob ^ (((ob >> 9) & 1) << 5)); }
__host__ __device__ __forceinline__ void stage_rc(int b, int& R, int& C) { const int st = b / 1024, sb = b % 1024, swz = sb ^ (((sb >> 9) & 1) << 5); R = (st >> 1) * 16 + swz / 64; C = (st & 1) * 32 + (swz % 64) / 2; }
__host__ __device__ __forceinline__ int perm32(int rho) { const int n = rho >> 4, i = rho & 15; return 8 * (i >> 2) + 4 * n + (i & 3); }

struct Unit { int pm, pn, g; };
struct Gemm { const bf16_t* A; const bf16_t* Bt; int lda, ldb, K; size_t gsA, gsB; };

struct StaticOrder {
    int nM, nN, nwg, G, c;
    __host__ __device__ void init(int M, int N, int G_, int c_) { nM = M / BM; nN = N / BM; nwg = nM * nN; G = G_; c = c_; }
    __host__ __device__ bool next(int i, Unit& u) const {
        const long L = (long)i * G + c; if (L >= nwg) return false;
        int wgid = (int)L; { const int q = nwg / NXCD, r = nwg % NXCD, xcd = wgid % NXCD, off = wgid / NXCD; wgid = (xcd < r ? xcd * (q + 1) : r * (q + 1) + (xcd - r) * q) + off; }
        const int nig = WGM * nN, gid = wgid / nig, fm = gid * WGM, gsz = (nM - fm) < WGM ? (nM - fm) : WGM;
        u.pm = fm + ((wgid % nig) % gsz); u.pn = (wgid % nig) / gsz; u.g = 0; return true;
    }
    __device__ __forceinline__ void a_ready(const Unit&) const {}
    __device__ __forceinline__ void done(const Unit&) const {}
};

__device__ __forceinline__ unsigned cvt_pk_bf16(float lo, float hi) { unsigned r; asm volatile("v_cvt_pk_bf16_f32 %0, %1, %2" : "=v"(r) : "v"(lo), "v"(hi)); return r; }
typedef float f32x2 __attribute__((ext_vector_type(2)));
__device__ __forceinline__ f32x2 gelu_pk(f32x2 v) {
    const f32x2 av = __builtin_elementwise_abs(v), d = av * 0.2316418882f + 1.0f;
    f32x2 t; t.x = __builtin_amdgcn_rcpf(d.x); t.y = __builtin_amdgcn_rcpf(d.y);
    f32x2 q = t * 0.5307027145f + (-0.7265760135f); q = q * t + 0.7107068705f; q = q * t + (-0.142248368f); q = q * t + 0.127414796f; q = q * t;
    const f32x2 s = (v * v) * (-0.72134752044f);
    f32x2 e; e.x = __builtin_amdgcn_exp2f(s.x); e.y = __builtin_amdgcn_exp2f(s.y);
    const f32x2 m = v * (q * e), r = v - m;
    f32x2 o; o.x = v.x < 0.f ? m.x : r.x; o.y = v.y < 0.f ? m.y : r.y; return o;
}

template <int ACT  > struct EpiBf16 {
    static constexpr bool PERM = true, AFTER_DRAIN = false; static_assert(ACT == 0 || ACT == 1, "EpiBf16: ACT is 0 (none) or 1 (gelu_pk)");
    bf16_t* O; int ldc; const float* bias; int split_cols; size_t split_stride; float scale0;
    __device__ __forceinline__ void operator()(const f32x4 (&acc)[2][2][4][2], const Unit& u, int wr, int wc, int fr, int fq) const {
        const int row0 = u.pm * BM + wr * 64 + fr; int colt = u.pn * BM; bf16_t* base = O;
        float sc = 1.f; if (split_cols) { const int t = colt / split_cols; base += (size_t)t * split_stride; colt -= t * split_cols; if (t == 0) sc = scale0; }
        const int col0 = colt + wc * 32 + 8 * fq, bcol0 = u.pn * BM + wc * 32 + 8 * fq;
        f32x4 bv[2][2];
#pragma unroll
        for (int bj = 0; bj < 2; ++bj)
#pragma unroll
            for (int n = 0; n < 2; ++n) bv[bj][n] = bias ? *(const f32x4*)(bias + bcol0 + bj * HALF + 4 * n) : (f32x4){0.f, 0.f, 0.f, 0.f};
#pragma unroll
        for (int ai = 0; ai < 2; ++ai)
#pragma unroll
            for (int m = 0; m < 4; ++m) { bf16_t* rowp = base + (size_t)(row0 + ai * HALF + m * 16) * ldc + col0;
#pragma unroll
                for (int bj = 0; bj < 2; ++bj) { f32x4 v0 = acc[ai][bj][m][0] + bv[bj][0], v1 = acc[ai][bj][m][1] + bv[bj][1];
                    if (ACT == 1) { f32x2 a = gelu_pk((f32x2){v0[0], v0[1]}), b = gelu_pk((f32x2){v0[2], v0[3]}), c = gelu_pk((f32x2){v1[0], v1[1]}), d = gelu_pk((f32x2){v1[2], v1[3]});
                        v0 = (f32x4){a.x, a.y, b.x, b.y}; v1 = (f32x4){c.x, c.y, d.x, d.y}; }
                    v0 = v0 * sc; v1 = v1 * sc; u32x4 w; w.x = cvt_pk_bf16(v0[0], v0[1]); w.y = cvt_pk_bf16(v0[2], v0[3]); w.z = cvt_pk_bf16(v1[0], v1[1]); w.w = cvt_pk_bf16(v1[2], v1[3]);
                    *(u32x4*)(rowp + bj * HALF) = w; } }
    }
};
template <class Epi, class Sched, bool ALIGN_EPI = false, bool SP2 = false>
__device__ __forceinline__ void gemm_phase(PG8_LAS unsigned char* lds, const Gemm g, const Sched& S, const Epi& E) {
    int tid_ = threadIdx.x; asm volatile("" : "+v"(tid_));
    const int tid = tid_, wid = __builtin_amdgcn_readfirstlane(tid >> 6), lane = tid & 63, wr = wid >> 2, wc = wid & 3, fr = lane & 15, fq = lane >> 4;
    const int K = g.K, nt = K / BK;
    unsigned voffA[2], voffB[2];
#pragma unroll
    for (int i = 0; i < 2; ++i) { int R, C; stage_rc(tid * 16 + i * 8192, R, C); const int Rb = Epi::PERM ? ((R & ~31) + perm32(R & 31)) : R;
        voffA[i] = (unsigned)(R * g.lda + C) * 2u; voffB[i] = (unsigned)(Rb * g.ldb + C) * 2u; }
    const size_t kstep = (size_t)(BK * 2);
    const size_t hstepA = (size_t)HALF * g.lda * 2, hstepB = (size_t)HALF * g.ldb * 2;
    const size_t tstepA = 2 * hstepA, tstepB = 2 * hstepB;
    const unsigned ldsw = (unsigned)wid * 1024u;
    const int aoff = lds_byte(wr * 64 + fr, fq * 8), boff = lds_byte(wc * 32 + fr, fq * 8);
#define PG8_SA(b, h) (((b) * 2 + (h)) * HTB)
#define PG8_SB(b, h) ((4 + (b) * 2 + (h)) * HTB)
#define PG8_STAGE(bufoff, gbase, voff) do { _Pragma("unroll") for (int _i = 0; _i < 2; ++_i) \
        __builtin_amdgcn_global_load_lds((const unsigned*)((const char*)(gbase) + (voff)[_i]), (PG8_LAS unsigned*)(lds + (bufoff) + ldsw + _i * 8192), 16, 0, 0); } while (0)
#define PG8_LDA(dst, b, h) do { _Pragma("unroll") for (int m = 0; m < 4; ++m) _Pragma("unroll") for (int k = 0; k < 2; ++k) dst[m][k] = *(const PG8_LAS bf16x8*)(lds + PG8_SA(b, h) + aoff + m * 2048 + k * 1024); } while (0)
#define PG8_LDB(dst, b, h) do { _Pragma("unroll") for (int n = 0; n < 2; ++n) _Pragma("unroll") for (int k = 0; k < 2; ++k) dst[n][k] = *(const PG8_LAS bf16x8*)(lds + PG8_SB(b, h) + boff + n * 2048 + k * 1024); } while (0)
#define PG8_MMA(ai, bj, At, Bt) do { __builtin_amdgcn_s_setprio(1); _Pragma("unroll") for (int m = 0; m < 4; ++m) _Pragma("unroll") for (int n = 0; n < 2; ++n) _Pragma("unroll") for (int k = 0; k < 2; ++k) \
        acc[ai][bj][m][n] = __builtin_amdgcn_mfma_f32_16x16x32_bf16(Bt[n][k], At[m][k], acc[ai][bj][m][n], 0, 0, 0); __builtin_amdgcn_s_setprio(0); } while (0)
#define PG8_WAIT_V(n) asm volatile("s_waitcnt vmcnt(" #n ")" ::: "memory")
#define PG8_WAIT_L(n) asm volatile("s_waitcnt lgkmcnt(" #n ")" ::: "memory")
#define PG8_BAR __builtin_amdgcn_s_barrier()
#define PG8_SCHED __builtin_amdgcn_sched_barrier(0)
    Unit cur, nxt; int ui = 0;
    if (!S.next(0, cur)) return;
    f32x4 acc[2][2][4][2];
#pragma unroll
    for (int a = 0; a < 2; ++a)
#pragma unroll
        for (int b = 0; b < 2; ++b)
#pragma unroll
            for (int m = 0; m < 4; ++m)
#pragma unroll
                for (int n = 0; n < 2; ++n) acc[a][b][m][n] = (f32x4){0.f, 0.f, 0.f, 0.f};
    bf16x8 At[4][2], B0[2][2], B1[2][2];
    const char* cA = (const char*)g.A + (size_t)cur.g * g.gsA * 2 + (size_t)cur.pm * tstepA; const char* cB = (const char*)g.Bt + (size_t)cur.g * g.gsB * 2 + (size_t)cur.pn * tstepB;
    S.a_ready(cur);
    if constexpr (SP2) {
        PG8_STAGE(PG8_SB(0, 0), cB, voffB); PG8_STAGE(PG8_SB(0, 1), cB + hstepB, voffB); PG8_STAGE(PG8_SA(0, 0), cA, voffA); PG8_STAGE(PG8_SA(0, 1), cA + hstepA, voffA);
        if (wr == 1) PG8_BAR;
        PG8_WAIT_V(2); PG8_BAR;
        PG8_STAGE(PG8_SB(1, 0), cB + kstep, voffB); PG8_STAGE(PG8_SA(1, 0), cA + kstep, voffA); PG8_STAGE(PG8_SB(1, 1), cB + hstepB + kstep, voffB);
        PG8_WAIT_V(6); PG8_BAR;
    } else {
        PG8_STAGE(PG8_SB(0, 0), cB, voffB); PG8_STAGE(PG8_SA(0, 0), cA, voffA); PG8_STAGE(PG8_SB(0, 1), cB + hstepB, voffB); PG8_STAGE(PG8_SA(0, 1), cA + hstepA, voffA);
        if (wr == 1) PG8_BAR;
        PG8_WAIT_V(4); PG8_BAR;
        PG8_STAGE(PG8_SB(1, 0), cB + kstep, voffB); PG8_STAGE(PG8_SA(1, 0), cA + kstep, voffA); PG8_STAGE(PG8_SB(1, 1), cB + hstepB + kstep, voffB);
        PG8_WAIT_V(6); PG8_BAR;
    }
    for (;;) {
        const bool has_next = S.next(ui + 1, nxt);
        const char* nA = has_next ? (const char*)g.A + (size_t)nxt.g * g.gsA * 2 + (size_t)nxt.pm * tstepA : cA; const char* nB = has_next ? (const char*)g.Bt + (size_t)nxt.g * g.gsB * 2 + (size_t)nxt.pn * tstepB : cB;
        for (int t = 0; t < nt; t += 2) {
            const bool last = (t == nt - 2);
            const char* a1 = cA + (size_t)(t + 1) * kstep;
            const char* a2 = last ? nA : cA + (size_t)(t + 2) * kstep; const char* b2 = last ? nB : cB + (size_t)(t + 2) * kstep;
            const char* a3 = a2 + kstep; const char* b3 = b2 + kstep;
            if (last && has_next) S.a_ready(nxt);
            if constexpr (SP2) {
            PG8_LDB(B0, 0, 0); PG8_LDB(B1, 0, 1); PG8_SCHED; PG8_LDA(At, 0, 0); PG8_STAGE(PG8_SA(1, 1), a1 + hstepA, voffA);
            PG8_WAIT_V(8); PG8_WAIT_L(0); PG8_BAR; PG8_MMA(0, 0, At, B0); PG8_MMA(0, 1, At, B1); PG8_BAR; PG8_SCHED;
            PG8_LDA(At, 0, 1); PG8_STAGE(PG8_SB(0, 0), b2, voffB); PG8_STAGE(PG8_SB(0, 1), b2 + hstepB, voffB); PG8_STAGE(PG8_SA(0, 0), a2, voffA);
            PG8_WAIT_V(8); PG8_WAIT_L(0); PG8_BAR; PG8_MMA(1, 0, At, B0); PG8_MMA(1, 1, At, B1); PG8_BAR; PG8_SCHED;
            PG8_LDB(B0, 1, 0); PG8_LDB(B1, 1, 1); PG8_SCHED; PG8_LDA(At, 1, 0); PG8_STAGE(PG8_SA(0, 1), a2 + hstepA, voffA);
            PG8_WAIT_V(8); PG8_WAIT_L(0); PG8_BAR; PG8_MMA(0, 0, At, B0); PG8_MMA(0, 1, At, B1); PG8_BAR; PG8_SCHED;
            PG8_LDA(At, 1, 1); PG8_STAGE(PG8_SB(1, 0), b3, voffB); PG8_STAGE(PG8_SB(1, 1), b3 + hstepB, voffB); PG8_STAGE(PG8_SA(1, 0), a3, voffA);
            PG8_WAIT_V(8); PG8_WAIT_L(0); PG8_BAR; PG8_MMA(1, 0, At, B0); PG8_MMA(1, 1, At, B1); PG8_BAR; PG8_SCHED;
            } else {
            PG8_LDB(B0, 0, 0); PG8_SCHED; PG8_LDA(At, 0, 0); PG8_STAGE(PG8_SA(1, 1), a1 + hstepA, voffA);
            PG8_WAIT_L(8); PG8_BAR; PG8_WAIT_L(0); PG8_MMA(0, 0, At, B0); PG8_BAR; PG8_SCHED;
            PG8_LDB(B1, 0, 1); PG8_STAGE(PG8_SB(0, 0), b2, voffB);
            PG8_BAR; PG8_WAIT_L(0); PG8_MMA(0, 1, At, B1); PG8_BAR;
            PG8_LDA(At, 0, 1); PG8_STAGE(PG8_SA(0, 0), a2, voffA);
            PG8_BAR; PG8_WAIT_L(0); PG8_MMA(1, 0, At, B0); PG8_BAR; PG8_SCHED;
            PG8_STAGE(PG8_SB(0, 1), b2 + hstepB, voffB);
            PG8_WAIT_V(6); PG8_BAR; PG8_MMA(1, 1, At, B1); PG8_BAR;
            PG8_LDB(B0, 1, 0); PG8_SCHED; PG8_LDA(At, 1, 0); PG8_STAGE(PG8_SA(0, 1), a2 + hstepA, voffA);
            PG8_WAIT_L(8); PG8_BAR; PG8_WAIT_L(0); PG8_MMA(0, 0, At, B0); PG8_BAR; PG8_SCHED;
            PG8_LDB(B1, 1, 1); PG8_STAGE(PG8_SB(1, 0), b3, voffB);
            PG8_BAR; PG8_WAIT_L(0); PG8_MMA(0, 1, At, B1); PG8_BAR;
            PG8_LDA(At, 1, 1); PG8_STAGE(PG8_SA(1, 0), a3, voffA);
            PG8_BAR; PG8_WAIT_L(0); PG8_MMA(1, 0, At, B0); PG8_BAR; PG8_SCHED;
            PG8_STAGE(PG8_SB(1, 1), b3 + hstepB, voffB);
            PG8_WAIT_V(6); PG8_BAR; PG8_MMA(1, 1, At, B1); PG8_BAR;
            }
        }
        if constexpr (ALIGN_EPI) { if (wr == 0) PG8_BAR; }
        if constexpr (!Epi::AFTER_DRAIN) { E(acc, cur, wr, wc, fr, fq); S.done(cur); }
        if (!has_next) break;
#pragma unroll
        for (int a = 0; a < 2; ++a)
#pragma unroll
            for (int b = 0; b < 2; ++b)
#pragma unroll
                for (int m = 0; m < 4; ++m)
#pragma unroll
                    for (int n = 0; n < 2; ++n) acc[a][b][m][n] = (f32x4){0.f, 0.f, 0.f, 0.f};
        cur = nxt; cA = nA; cB = nB; ++ui;
        if constexpr (ALIGN_EPI) { if (wr == 1) PG8_BAR; }
    }
    PG8_WAIT_V(0);
    if constexpr (!ALIGN_EPI) { if (wr == 0) PG8_BAR; }
    PG8_BAR;
    if constexpr (Epi::AFTER_DRAIN) { E.fused(acc, cur, wr, wc, fr, fq, lds, wid, lane); S.done(cur); }
#undef PG8_SA
#undef PG8_SB
#undef PG8_STAGE
#undef PG8_LDA
#undef PG8_LDB
#undef PG8_MMA
#undef PG8_WAIT_V
#undef PG8_WAIT_L
#undef PG8_BAR
#undef PG8_SCHED
}
}

#ifndef PG8_SP2
#define PG8_SP2 true
#endif
#ifndef PG8_ALIGN
#define PG8_ALIGN true
#endif
#include <hip/hip_bf16.h>
#include <cmath>
namespace attn_body {
using bf16=__hip_bfloat16;
using bf16x8=__attribute__((ext_vector_type(8)))short;
using s16x4=__attribute__((ext_vector_type(4)))short;
using f32x16=__attribute__((ext_vector_type(16)))float;
using u32x4=__attribute__((ext_vector_type(4)))unsigned;
constexpr int BATCH=8,SEQ=4096,D=64,DM=1024,DMO=1024;
constexpr int NW=8,QBLK=32,QB=QBLK*NW,KVBLK=64,NQB=SEQ/QB;
constexpr int ATTN_PITCH=DM, ATTN_UNIT_ROWS=QB;
__device__ __forceinline__ int crow(int r,int hi){return (r&3)+8*(r>>2)+4*hi;}
#define SBAR() __builtin_amdgcn_sched_barrier(0)
__device__ __forceinline__ void cmask(f32x16&p0,f32x16&p1,int jb,int qrel,int hi){
  const float NEG=-INFINITY; int kb=64*jb+4*hi;
  #pragma unroll
  for(int r=0;r<16;++r){int kv=kb+(r&3)+8*(r>>2); if(kv>qrel)p0[r]=NEG; if(kv+32>qrel)p1[r]=NEG;}
}

constexpr int NSLOT=3, SLOTB=8192;
constexpr int LDS_K=0, LDS_V=NSLOT*SLOTB, LDS_WS=LDS_V+NSLOT*2*SLOTB, LDS_OST=LDS_WS+NW*64*4, LDS_BYTES=LDS_OST+NW*4096;
constexpr float C2=0.125f*1.4426950408889634f;
__device__ __forceinline__ void glds16(const void*gsrc,unsigned lds_dst){unsigned keep;
  asm volatile("s_mov_b32 %0, m0\n\ts_mov_b32 m0, %2\n\ts_nop 0\n\tglobal_load_lds_dwordx4 %1, off\n\ts_mov_b32 m0, %0":"=&s"(keep):"v"(gsrc),"s"(lds_dst):"memory");}
__device__ __forceinline__ float max3f(float a,float b,float c){float r;asm("v_max3_f32 %0, %1, %2, %3":"=v"(r):"v"(a),"v"(b),"v"(c));return r;}
__device__ __forceinline__ float max2f(float a,float b){float r;asm("v_max_f32_e32 %0, %1, %2":"=v"(r):"v"(a),"v"(b));return r;}
__device__ __forceinline__ float fadd_s(float a,float b){float r;asm("v_add_f32_e32 %0, %1, %2":"=v"(r):"v"(a),"v"(b));return r;}
__device__ __forceinline__ float fsub_s(float a,float b){float r;asm("v_sub_f32_e32 %0, %1, %2":"=v"(r):"v"(a),"v"(b));return r;}
typedef float f32x2_t __attribute__((ext_vector_type(2))); typedef __bf16 bf16x2_t __attribute__((ext_vector_type(2)));
__device__ __forceinline__ unsigned cvtpk_s(float lo,float hi){f32x2_t v={lo,hi};bf16x2_t b=__builtin_convertvector(v,bf16x2_t);return __builtin_bit_cast(unsigned,b);}
#define WAIT_BAR(N) asm volatile("s_waitcnt vmcnt(" #N ") lgkmcnt(0)\n\ts_barrier":::"memory")

__device__ __forceinline__ void qkt(f32x16&p0,f32x16&p1,const char*Kslot,const bf16x8*qr,int r32,int hi){
  const char*kb=Kslot+hi*1024+r32*16;
  #pragma unroll
  for(int d0=0;d0<4;++d0){
    const bf16x8 b0=*reinterpret_cast<const bf16x8*>(kb+d0*2048);
    const bf16x8 b1=*reinterpret_cast<const bf16x8*>(kb+d0*2048+512);
    if(d0==0){p0=__builtin_amdgcn_mfma_f32_32x32x16_bf16(b0,qr[0],f32x16{},0,0,0);p1=__builtin_amdgcn_mfma_f32_32x32x16_bf16(b1,qr[0],f32x16{},0,0,0);}
    else{p0=__builtin_amdgcn_mfma_f32_32x32x16_bf16(b0,qr[d0],p0,0,0,0);p1=__builtin_amdgcn_mfma_f32_32x32x16_bf16(b1,qr[d0],p1,0,0,0);}}
}
typedef __attribute__((address_space(3))) const char* lds_cptr;
typedef short v4i16_t __attribute__((ext_vector_type(4)));
__device__ __forceinline__ void kload8(bf16x8*kf,lds_cptr kp){
  kf[0]=*(const __attribute__((address_space(3))) bf16x8*)(kp);      kf[1]=*(const __attribute__((address_space(3))) bf16x8*)(kp+512);
  kf[2]=*(const __attribute__((address_space(3))) bf16x8*)(kp+2048); kf[3]=*(const __attribute__((address_space(3))) bf16x8*)(kp+2560);
  kf[4]=*(const __attribute__((address_space(3))) bf16x8*)(kp+4096); kf[5]=*(const __attribute__((address_space(3))) bf16x8*)(kp+4608);
  kf[6]=*(const __attribute__((address_space(3))) bf16x8*)(kp+6144); kf[7]=*(const __attribute__((address_space(3))) bf16x8*)(kp+6656);
}
__device__ __forceinline__ void kload2(bf16x8*kf,lds_cptr kp,int j){ kf[2*j]=*(const __attribute__((address_space(3))) bf16x8*)(kp+j*2048); kf[2*j+1]=*(const __attribute__((address_space(3))) bf16x8*)(kp+j*2048+512); }
__device__ __forceinline__ s16x4 vtr(lds_cptr p){ return __builtin_bit_cast(s16x4,__builtin_amdgcn_ds_read_tr16_b64_v4i16((__attribute__((address_space(3))) v4i16_t*)p)); }
__device__ __forceinline__ float rowmax(const f32x16&p0,const f32x16&p1){
  float a=max3f(p0[0],p0[1],p1[0]),b=max3f(p0[2],p0[3],p1[1]);a=max3f(a,p1[2],p1[3]);
  #pragma unroll
  for(int r=4;r<16;r+=4){a=max3f(a,p0[r],p0[r+1]);b=max3f(b,p0[r+2],p0[r+3]);a=max3f(a,p1[r],p1[r+1]);b=max3f(b,p1[r+2],p1[r+3]);}
  const float m=max2f(a,b);
  auto rr=__builtin_amdgcn_permlane32_swap(__float_as_uint(m),__float_as_uint(m),false,false);
  return max2f(__uint_as_float(rr[0]),__uint_as_float(rr[1]));
}
__device__ __forceinline__ void pv(f32x16*o,int vb,bf16x8 pa0,bf16x8 pa1,bf16x8 pa2,bf16x8 pa3){
  #pragma unroll
  for(int d0=0;d0<2;++d0){s16x4 lo[4],hi[4];
    #pragma unroll
    for(int ks=0;ks<4;++ks){
      asm volatile("ds_read_b64_tr_b16 %0,%1 offset:%c2":"=&v"(lo[ks]):"v"(vb),"i"(d0*4096+ks*1024):"memory");
      asm volatile("ds_read_b64_tr_b16 %0,%1 offset:%c2":"=&v"(hi[ks]):"v"(vb),"i"(d0*4096+ks*1024+512):"memory");}
    asm volatile("s_waitcnt lgkmcnt(0)":::"memory");SBAR();
    #define PK(k) (bf16x8){lo[k][0],lo[k][1],lo[k][2],lo[k][3],hi[k][0],hi[k][1],hi[k][2],hi[k][3]}
    o[d0]=__builtin_amdgcn_mfma_f32_32x32x16_bf16(pa0,PK(0),o[d0],0,0,0);
    o[d0]=__builtin_amdgcn_mfma_f32_32x32x16_bf16(pa1,PK(1),o[d0],0,0,0);
    o[d0]=__builtin_amdgcn_mfma_f32_32x32x16_bf16(pa2,PK(2),o[d0],0,0,0);
    o[d0]=__builtin_amdgcn_mfma_f32_32x32x16_bf16(pa3,PK(3),o[d0],0,0,0);
    #undef PK
  }
}

#ifndef ATTN_STORE16
#define ATTN_STORE16(p,v) (*(u32x4*)(p)=(v))
#endif
template<int THRL,int MODE> __device__ __forceinline__ void attn_unit(int b,int qb,const bf16*Q,const bf16*__restrict__ K,const bf16*__restrict__ V,bf16*O,bf16*O2,char*shm,bf16*CM,float lam,const float*gn){
  int tid_=threadIdx.x; asm volatile("":"+v"(tid_)); const int tid=tid_,lane=tid&63,r32=lane&31,hi=lane>>5; const int wid=__builtin_amdgcn_readfirstlane(tid>>6);
  const long rowbase=(long)b*SEQ; const int q0=qb*QB;
  const bf16*Qw=Q+(rowbase+q0+wid*QBLK)*DM;
  const bf16*Kh=K+rowbase*DM,*Vh=V+rowbase*DM;
  const unsigned lds0=(unsigned)(uintptr_t)shm;
  float*wsf=(float*)(shm+LDS_WS)+wid*64;
  const bf16*ksrc=Kh+(long)lane*DM+wid*8;
  const bf16*vsrc=Vh+(long)(16*(wid&3)+(lane>>2))*DM+(wid>>2)*32+(lane&3)*8;
  const unsigned kdst=lds0+LDS_K+wid*1024, vdst=lds0+LDS_V+wid*1024;
  #define DMA_K(t,slot) glds16(ksrc+(long)(t)*KVBLK*DM,(unsigned)__builtin_amdgcn_readfirstlane(kdst+(slot)))
  #define DMA_V(t,slot) do{ glds16(vsrc+(long)(t)*KVBLK*DM,(unsigned)__builtin_amdgcn_readfirstlane(vdst+2*(slot))); glds16(vsrc+64+(long)(t)*KVBLK*DM,(unsigned)__builtin_amdgcn_readfirstlane(vdst+2*(slot)+8192)); }while(0)
  const int vb0=(int)(lds0+LDS_V)+((lane>>4)&1)*32+(lane&3)*8+(4*hi+((lane&15)>>2))*64;
  const char*Kbase=shm+LDS_K; bf16x8 kf[8];
  const lds_cptr shm3=(lds_cptr)shm; const lds_cptr kp0=shm3+LDS_K+hi*1024+r32*16; const lds_cptr vp0=shm3+LDS_V+((lane>>4)&1)*32+(lane&3)*8+(4*hi+((lane&15)>>2))*64;
  const int NT=(q0+QB)/KVBLK;
  DMA_K(0,0);DMA_V(0,0);DMA_K(1,SLOTB);
  bf16x8 qr[4];
  #pragma unroll
  for(int d0=0;d0<4;++d0)qr[d0]=*reinterpret_cast<const bf16x8*>(&Qw[(long)r32*DM+d0*16+hi*8]);
  float mhat=0.f,l_reg=0.f;f32x16 o[4];o[0]=f32x16{};o[1]=f32x16{};o[2]=f32x16{};o[3]=f32x16{};
  const int qrel=wid*QBLK+r32;
  #define CMASK(P0,P1,t) do{int jb_=(t)-(NT-4); if(jb_>=0)cmask(P0,P1,jb_,qrel,hi);}while(0)
  bool resc=false;
  #define START(P0,P1) do{ const float rm=rowmax(P0,P1); resc=false; mhat=fadd_s(mhat,rm); \
    _Pragma("unroll") for(int r=0;r<16;++r){P0[r]=fsub_s(P0[r],mhat);P1[r]=fsub_s(P1[r],mhat);} \
    _Pragma("unroll") for(int r=0;r<16;++r)P0[r]=__builtin_amdgcn_exp2f(P0[r]); }while(0)
  #define RESC() do{ if(resc){ asm volatile("s_waitcnt lgkmcnt(0)":::"memory"); \
      _Pragma("unroll") for(int d_=0;d_<4;++d_) _Pragma("unroll") for(int r=0;r<16;++r)o[d_][r]*=wsf[crow(r,hi)]; } }while(0)
  f32x16 pA0,pA1,pB0,pB1;
  int sl_prev=0,sl_cur=0,sl_next=SLOTB;
  #define ROT() do{sl_prev=sl_cur;sl_cur=sl_next;sl_next=(sl_next==(NSLOT-1)*SLOTB)?0:sl_next+SLOTB;}while(0)
  DMA_K(2,2*SLOTB);
  WAIT_BAR(4);
  qkt(pA0,pA1,Kbase,qr,r32,hi);asm volatile("s_nop 15\n\ts_nop 7":"+v"(pA0),"+v"(pA1));CMASK(pA0,pA1,0);
  START(pA0,pA1);
  _Pragma("unroll") for(int r=0;r<16;++r)pA1[r]=__builtin_amdgcn_exp2f(pA1[r]);
  WAIT_BAR(0);
  DMA_K(3,0);DMA_V(1,SLOTB);
  ROT();
  kload8(kf,kp0+sl_cur);
  WAIT_BAR(3);
  s16x4 vlo[8],vhi[8]; u32x4 pw0,pw1,pw2,pw3;
  #define PKW(P,B) cvtpk_s(P[B],P[B+1])
  #define PAF(k) __builtin_bit_cast(bf16x8,pw##k)
  #define VFR(i) (bf16x8){vlo[i][0],vlo[i][1],vlo[i][2],vlo[i][3],vhi[i][0],vhi[i][1],vhi[i][2],vhi[i][3]}
  #define PIN(x) asm volatile("":"+v"(x))
  #define MX3(a,b,c) __builtin_fmaxf(__builtin_fmaxf((a),(b)),(c))
  #define GAPA(MF,A0,A1,A2,A3,W0,W1,PW) do{ MF; sacc+=A0; sacc+=A1; sacc+=A2; sacc+=A3; PIN(sacc); W0; W1; PIN(PW); SBAR(); }while(0)
  #define EX(v) __builtin_amdgcn_exp2f(v)
  #define GAPB(MF,X,B) do{ MF; X[B]=EX(X[B]-mhat); X[B+1]=EX(X[B+1]-mhat); X[B+2]=EX(X[B+2]-mhat); X[B+3]=EX(X[B+3]-mhat); PIN(X); SBAR(); }while(0)
  #define GAPB2(MF,X,B) do{ MF; X[B]=EX(X[B]-mhat); X[B+1]=EX(X[B+1]-mhat); PIN(X); SBAR(); }while(0)
  #define VRD2(i) do{ vlo[i]=vtr(vp_+(8192+((i)>>2)*4096+((i)&3)*1024)); vhi[i]=vtr(vp_+(8192+((i)>>2)*4096+((i)&3)*1024+512)); SBAR(); }while(0)
  #define VRD(i) do{ vlo[i]=vtr(vp_+(((i)>>2)*4096+((i)&3)*1024)); vhi[i]=vtr(vp_+(((i)>>2)*4096+((i)&3)*1024+512)); }while(0)
  #define KRD(G,j) do{ if(G){ kload2(kf,kp0+sl_next,j); SBAR(); } }while(0)
  #define STEP(C0,C1,P0,P1,t,GK,GV,GL) do{ SBAR(); \
    const lds_cptr vp_=vp0+2*sl_prev; \
    VRD(0); SBAR(); float sacc=(P0[0]+P0[1]); \
    GAPA(C0=__builtin_amdgcn_mfma_f32_32x32x16_bf16(kf[0],qr[0],f32x16{},0,0,0), P0[2],P0[3],P0[4],P0[5],     pw0[0]=PKW(P0,0), pw0[1]=PKW(P0,2), pw0); \
    VRD(4); SBAR(); GAPA(C1=__builtin_amdgcn_mfma_f32_32x32x16_bf16(kf[1],qr[0],f32x16{},0,0,0), P0[6],P0[7],P0[8],P0[9],     pw0[2]=PKW(P0,4), pw0[3]=PKW(P0,6), pw0); \
    VRD(1); SBAR(); GAPA(C0=__builtin_amdgcn_mfma_f32_32x32x16_bf16(kf[2],qr[1],C0,0,0,0),   P0[10],P0[11],P0[12],P0[13], pw1[0]=PKW(P0,8), pw1[1]=PKW(P0,10), pw1); \
    VRD(5); SBAR(); GAPA(C1=__builtin_amdgcn_mfma_f32_32x32x16_bf16(kf[3],qr[1],C1,0,0,0),   P0[14],P0[15],P1[0],P1[1],   pw1[2]=PKW(P0,12),pw1[3]=PKW(P0,14), pw1); \
    VRD(2); SBAR(); GAPA(C0=__builtin_amdgcn_mfma_f32_32x32x16_bf16(kf[4],qr[2],C0,0,0,0),   P1[2],P1[3],P1[4],P1[5],     pw2[0]=PKW(P1,0), pw2[1]=PKW(P1,2), pw2); \
    VRD(6); SBAR(); GAPA(C1=__builtin_amdgcn_mfma_f32_32x32x16_bf16(kf[5],qr[2],C1,0,0,0),   P1[6],P1[7],P1[8],P1[9],     pw2[2]=PKW(P1,4), pw2[3]=PKW(P1,6), pw2); \
    VRD(3); SBAR(); GAPA(C0=__builtin_amdgcn_mfma_f32_32x32x16_bf16(kf[6],qr[3],C0,0,0,0),   P1[10],P1[11],P1[12],P1[13], pw3[0]=PKW(P1,8), pw3[1]=PKW(P1,10), pw3); \
    VRD(7); SBAR(); GAPA(C1=__builtin_amdgcn_mfma_f32_32x32x16_bf16(kf[7],qr[3],C1,0,0,0),   P1[14],P1[15],0.f,0.f,       pw3[2]=PKW(P1,12),pw3[3]=PKW(P1,14), pw3); \
    l_reg+=sacc; \
    if(GK){DMA_K((t)+3,sl_cur);} if(GV){DMA_V((t)+1,sl_next);} \
    CMASK(C0,C1,t); \
    { float a=MX3(C0[0],C0[1],C1[0]),b=MX3(C0[2],C0[3],C1[1]); a=MX3(a,C1[2],C1[3]); \
      _Pragma("unroll") for(int r=4;r<16;r+=4){a=MX3(a,C0[r],C0[r+1]);b=MX3(b,C0[r+2],C0[r+3]);a=MX3(a,C1[r],C1[r+1]);b=MX3(b,C1[r+2],C1[r+3]);} \
      float rm=__builtin_fmaxf(a,b); { auto rr=__builtin_amdgcn_permlane32_swap(__float_as_uint(rm),__float_as_uint(rm),false,false); rm=__builtin_fmaxf(__uint_as_float(rr[0]),__uint_as_float(rr[1])); } \
      resc=false; rm-=mhat; \
      if(__builtin_expect(__any(rm>(float)THRL),0)){ const float dl=__builtin_fmaxf(rm,0.f); mhat+=dl; \
        const float f=__builtin_amdgcn_exp2f(-dl); l_reg*=f; if(hi==0)wsf[r32]=f; resc=true; } } \
    SBAR(); \
    GAPB2(o[0]=__builtin_amdgcn_mfma_f32_32x32x16_bf16(PAF(0),VFR(0),o[0],0,0,0), C0,0); VRD2(0); \
    GAPB2(o[1]=__builtin_amdgcn_mfma_f32_32x32x16_bf16(PAF(0),VFR(4),o[1],0,0,0), C0,2); VRD2(4); \
    KRD(GL,0); GAPB2(o[0]=__builtin_amdgcn_mfma_f32_32x32x16_bf16(PAF(1),VFR(1),o[0],0,0,0), C0,4); VRD2(1); \
    KRD(GL,1); GAPB2(o[1]=__builtin_amdgcn_mfma_f32_32x32x16_bf16(PAF(1),VFR(5),o[1],0,0,0), C0,6); VRD2(5); \
    KRD(GL,2); GAPB2(o[0]=__builtin_amdgcn_mfma_f32_32x32x16_bf16(PAF(2),VFR(2),o[0],0,0,0), C0,8); VRD2(2); \
    KRD(GL,3); GAPB2(o[1]=__builtin_amdgcn_mfma_f32_32x32x16_bf16(PAF(2),VFR(6),o[1],0,0,0), C0,10); VRD2(6); \
    GAPB2(o[0]=__builtin_amdgcn_mfma_f32_32x32x16_bf16(PAF(3),VFR(3),o[0],0,0,0), C0,12); VRD2(3); \
    GAPB2(o[1]=__builtin_amdgcn_mfma_f32_32x32x16_bf16(PAF(3),VFR(7),o[1],0,0,0), C0,14); VRD2(7); \
    GAPB2(o[2]=__builtin_amdgcn_mfma_f32_32x32x16_bf16(PAF(0),VFR(0),o[2],0,0,0), C1,0); \
    GAPB2(o[3]=__builtin_amdgcn_mfma_f32_32x32x16_bf16(PAF(0),VFR(4),o[3],0,0,0), C1,2); \
    GAPB2(o[2]=__builtin_amdgcn_mfma_f32_32x32x16_bf16(PAF(1),VFR(1),o[2],0,0,0), C1,4); \
    GAPB2(o[3]=__builtin_amdgcn_mfma_f32_32x32x16_bf16(PAF(1),VFR(5),o[3],0,0,0), C1,6); \
    GAPB2(o[2]=__builtin_amdgcn_mfma_f32_32x32x16_bf16(PAF(2),VFR(2),o[2],0,0,0), C1,8); \
    GAPB2(o[3]=__builtin_amdgcn_mfma_f32_32x32x16_bf16(PAF(2),VFR(6),o[3],0,0,0), C1,10); \
    GAPB2(o[2]=__builtin_amdgcn_mfma_f32_32x32x16_bf16(PAF(3),VFR(3),o[2],0,0,0), C1,12); \
    GAPB2(o[3]=__builtin_amdgcn_mfma_f32_32x32x16_bf16(PAF(3),VFR(7),o[3],0,0,0), C1,14); \
    }while(0)
  int t=1;
  #undef CMASK
  #define CMASK(P0,P1,t) do{}while(0)
  for(;t+5<NT;t+=2){
    STEP(pB0,pB1,pA0,pA1,t,true,true,true);     WAIT_BAR(3); RESC(); ROT();
    STEP(pA0,pA1,pB0,pB1,t+1,true,true,true);   WAIT_BAR(3); RESC(); ROT();
  }
  #undef CMASK
  #define CMASK(P0,P1,t) do{int jb_=(t)-(NT-4); if(jb_>=0)cmask(P0,P1,jb_,qrel,hi);}while(0)
  #define ENDW(tt) do{ if((tt)+3<NT){WAIT_BAR(3);} else if((tt)+2<NT){WAIT_BAR(2);} else {WAIT_BAR(0);} }while(0)
  for(;t+1<NT;t+=2){
    STEP(pB0,pB1,pA0,pA1,t,(t+3<NT),(t+1<NT),(t+1<NT));       ENDW(t);   RESC(); ROT();
    STEP(pA0,pA1,pB0,pB1,t+1,(t+4<NT),(t+2<NT),(t+2<NT));     ENDW(t+1); RESC(); ROT();
  }
  STEP(pB0,pB1,pA0,pA1,NT-1,false,false,false); RESC();
  { float sacc=pB0[0]+pB0[1]; _Pragma("unroll") for(int r=2;r<16;++r)sacc+=pB0[r]; _Pragma("unroll") for(int r=0;r<16;++r)sacc+=pB1[r]; l_reg+=sacc;
    pw0=(u32x4){PKW(pB0,0),PKW(pB0,2),PKW(pB0,4),PKW(pB0,6)};pw1=(u32x4){PKW(pB0,8),PKW(pB0,10),PKW(pB0,12),PKW(pB0,14)};pw2=(u32x4){PKW(pB1,0),PKW(pB1,2),PKW(pB1,4),PKW(pB1,6)};pw3=(u32x4){PKW(pB1,8),PKW(pB1,10),PKW(pB1,12),PKW(pB1,14)};
    SBAR(); pv(o,vb0+2*sl_cur,PAF(0),PAF(1),PAF(2),PAF(3)); pv(o+2,vb0+2*sl_cur+8192,PAF(0),PAF(1),PAF(2),PAF(3)); }
  #undef PKW
  #undef PAF
  #undef VFR
  #undef PIN
  #undef MX3
  #undef GAPA
  #undef GAPB
  #undef GAPB2
  #undef EX
  #undef VRD
  #undef VRD2
  #undef KRD
  #undef STEP
  #undef ENDW
  {auto rr=__builtin_amdgcn_permlane32_swap(__float_as_uint(l_reg),__float_as_uint(l_reg),false,false);l_reg=__uint_as_float(rr[0])+__uint_as_float(rr[1]);}
  if(hi==0)wsf[32+r32]=l_reg;asm volatile("s_waitcnt lgkmcnt(0)":::"memory");
  float rli[16];
  #pragma unroll
  for(int r=0;r<16;++r)rli[r]=__builtin_amdgcn_rcpf(wsf[32+crow(r,hi)]);
  if constexpr(MODE==0){
  #pragma unroll
  for(int hf=0;hf<2;++hf){ bf16*Ow=(hf?O2:O)+(rowbase+q0+wid*QBLK)*DMO;
    bf16*stg=(bf16*)(shm+LDS_OST)+wid*2048;
    #pragma unroll
    for(int r=0;r<16;++r){const int orow=crow(r,hi);
      #pragma unroll
      for(int d0=0;d0<2;++d0)stg[orow*64+d0*32+r32]=__float2bfloat16(o[2*hf+d0][r]*rli[r]);}
    asm volatile("s_waitcnt lgkmcnt(0)":::"memory");
    #pragma unroll
    for(int i=0;i<4;++i){const int row=i*8+(lane>>3),ch=lane&7; const u32x4 v=*(const u32x4*)(stg+row*64+ch*8); ATTN_STORE16(Ow+(long)row*DMO+ch*8,v);}
    asm volatile("s_waitcnt lgkmcnt(0)":::"memory"); }
  } else {
  float dv[2][4][8]; float ssq[4]={0.f,0.f,0.f,0.f}; const int ch=lane&7;
  #pragma unroll
  for(int hf=0;hf<2;++hf){ const bf16*Aw=(hf?O2:O)+(rowbase+q0+wid*QBLK)*DMO;
    bf16*stg=(bf16*)(shm+LDS_OST)+wid*2048;
    #pragma unroll
    for(int r=0;r<16;++r){const int orow=crow(r,hi);
      #pragma unroll
      for(int d0=0;d0<2;++d0)stg[orow*64+d0*32+r32]=__float2bfloat16(o[2*hf+d0][r]*rli[r]);}
    asm volatile("s_waitcnt lgkmcnt(0)":::"memory");
    #pragma unroll
    for(int i=0;i<4;++i){const int row=i*8+(lane>>3); const u32x4 v=*(const u32x4*)(stg+row*64+ch*8); const u32x4 a=*(const u32x4*)(Aw+(long)row*DMO+ch*8);
      #pragma unroll
      for(int k=0;k<4;++k){ const float d0_=__uint_as_float(a[k]<<16)-lam*__uint_as_float(v[k]<<16), d1_=__uint_as_float(a[k]&0xffff0000u)-lam*__uint_as_float(v[k]&0xffff0000u);
        dv[hf][i][2*k]=d0_; dv[hf][i][2*k+1]=d1_; ssq[i]+=d0_*d0_+d1_*d1_; } }
    asm volatile("s_waitcnt lgkmcnt(0)":::"memory"); }
  float rs[4];
  #pragma unroll
  for(int i=0;i<4;++i){ float t_=ssq[i]; t_+=__shfl_xor(t_,1); t_+=__shfl_xor(t_,2); t_+=__shfl_xor(t_,4); rs[i]=__builtin_amdgcn_rsqf(t_*(1.f/128.f)+1e-6f); }
  #pragma unroll
  for(int hf=0;hf<2;++hf){ float g[8];
    #pragma unroll
    for(int e=0;e<8;++e)g[e]=gn[hf*64+ch*8+e];
    #pragma unroll
    for(int i=0;i<4;++i){const int row=i*8+(lane>>3); u32x4 w;
      #pragma unroll
      for(int k=0;k<4;++k)w[k]=cvtpk_s(dv[hf][i][2*k]*rs[i]*g[2*k],dv[hf][i][2*k+1]*rs[i]*g[2*k+1]);
      *(u32x4*)(CM+(rowbase+q0+wid*QBLK+row)*DMO+hf*64+ch*8)=w; } }
  }
  asm volatile("s_waitcnt lgkmcnt(0)\n\ts_barrier":::"memory");
  #undef DMA_K
  #undef DMA_V
  #undef CMASK
  #undef START
  #undef RESC
  #undef ROT
}
constexpr int ATTN_LDS_BYTES=LDS_BYTES;
template<int THRL=8> __device__ __forceinline__ void attn_phase(char*lds,const bf16*P,bf16*OA,bf16*CM,long SPLIT,float lam,const float*gn,int G,int vcu){
  if(G==256){ const int xcd=vcu>>5,c=vcu&31,s=c&7;
    for(int r=0;r<2;++r){ const int hp=xcd*8+4*r+(c>>3),b=hp>>3,h8=hp&7;
      for(int k=0;k<2;++k){ const int qb=k?s:15-s;
        attn_unit<THRL,0>(b,qb,P+(2*h8)*64,P+SPLIT+(2*h8)*64,P+2*SPLIT+h8*128,OA+h8*128,OA+h8*128+64,lds,nullptr,0.f,nullptr);
        attn_unit<THRL,1>(b,qb,P+(2*h8+1)*64,P+SPLIT+(2*h8+1)*64,P+2*SPLIT+h8*128,OA+h8*128,OA+h8*128+64,lds,CM+h8*128,lam,gn); } }
  } else {
    for(int u=vcu;u<BATCH*8*NQB;u+=G){ const int hp=u>>4,qb=NQB-1-(u&15),b=hp>>3,h8=hp&7;
      attn_unit<THRL,0>(b,qb,P+(2*h8)*64,P+SPLIT+(2*h8)*64,P+2*SPLIT+h8*128,OA+h8*128,OA+h8*128+64,lds,nullptr,0.f,nullptr);
      attn_unit<THRL,1>(b,qb,P+(2*h8+1)*64,P+SPLIT+(2*h8+1)*64,P+2*SPLIT+h8*128,OA+h8*128,OA+h8*128+64,lds,CM+h8*128,lam,gn); }
  }
}
#undef SBAR
#undef WAIT_BAR
}
namespace cg = cooperative_groups;
#ifndef PROBE_ID
#define PROBE_ID 0
#endif
#define LAS __attribute__((address_space(3)))
typedef unsigned short bf16;
typedef float f32x4 __attribute__((ext_vector_type(4)));
typedef float f32x2 __attribute__((ext_vector_type(2)));
typedef unsigned v4u __attribute__((ext_vector_type(4)));
typedef unsigned v2u __attribute__((ext_vector_type(2)));
typedef short bf16x8 __attribute__((ext_vector_type(8)));
typedef short bf16x4 __attribute__((ext_vector_type(4)));

#define XB_TMO      128
#define XB_XCNT(j)  (256  + 64 * (j))
#define XB_XSUB(j)  (1280 + 64 * (j))
#define XB_XGEN(j)  (2304 + 64 * (j))
#define XB_TOP      3328
#define XB_TOPGEN   3392
#define XCD_BAR_WORDS 3456
#define XB_SPIN_CAP (1u << 18)

__device__ __forceinline__ unsigned xb_ld(unsigned* p)              { return __hip_atomic_load(p, __ATOMIC_RELAXED, __HIP_MEMORY_SCOPE_AGENT); }
__device__ __forceinline__ unsigned xb_add(unsigned* p, unsigned v) { return __hip_atomic_fetch_add(p, v, __ATOMIC_RELAXED, __HIP_MEMORY_SCOPE_AGENT); }
__device__ __forceinline__ unsigned xb_xcc_id() { return (unsigned)__builtin_amdgcn_s_getreg((3 << 11) | 20) & 0xFu; }
#define XB_SPIN(cond, bar) do { unsigned _sp = 0; while (cond) { __builtin_amdgcn_s_sleep(1); \
    if ((++_sp & 255u) == 0u) { if (xb_ld(&(bar)[XB_TMO])) break; if (_sp > XB_SPIN_CAP) { atomicAdd(&(bar)[XB_TMO], 1u); break; } } } } while (0)

struct XcdBarrier {
    unsigned* bar; unsigned x;
    volatile LAS unsigned* st;
};

__device__ __forceinline__ XcdBarrier xcd_barrier_post(unsigned* bar, volatile LAS unsigned* st) {
    XcdBarrier b; b.bar = bar; b.x = xb_xcc_id(); b.st = st;
    if (threadIdx.x == 0) (void)xb_add(&bar[XB_XCNT(b.x)], 1u);
    return b;
}
__device__ __forceinline__ void xcd_barrier_complete(unsigned* bar, unsigned x, unsigned& nloc, unsigned& nx) {
    const unsigned G = gridDim.x * gridDim.y * gridDim.z;
    unsigned sum, cnt, mine, sp = 0u;
    for (;;) {
        sum = 0u; cnt = 0u; mine = 0u;
#pragma unroll
        for (unsigned j = 0; j < 16; ++j) { const unsigned c = xb_ld(&bar[XB_XCNT(j)]); sum += c; cnt += (c > 0u) ? 1u : 0u; mine = (j == x) ? c : mine; }
        if (sum == G) break;
        __builtin_amdgcn_s_sleep(1);
        if ((++sp & 255u) == 0u) { if (xb_ld(&bar[XB_TMO])) break; if (sp > XB_SPIN_CAP) { atomicAdd(&bar[XB_TMO], 1u); break; } }
    }
    nloc = mine > 0u ? mine : 1u; nx = cnt > 0u ? cnt : 1u;
}

__device__ __forceinline__ void xcd_barrier(const XcdBarrier& b) {
    asm volatile("s_waitcnt vmcnt(0)" ::: "memory");
    __syncthreads();
    if (threadIdx.x == 0) {
        unsigned* bar = b.bar;
        __builtin_amdgcn_s_waitcnt(0);
        unsigned nloc = b.st[0], nx = b.st[1];
        if (nloc == 0u) { xcd_barrier_complete(bar, b.x, nloc, nx); b.st[0] = nloc; b.st[1] = nx; }
        const unsigned old = xb_add(&bar[XB_XSUB(b.x)], 1u);
        const unsigned gen = old / nloc;
        if (old + 1u == (gen + 1u) * nloc) {
            __builtin_amdgcn_fence(__ATOMIC_RELEASE, "agent");
            asm volatile("s_waitcnt vmcnt(0)" ::: "memory");
            const unsigned og = xb_add(&bar[XB_TOP], 1u);
            const unsigned tg = og / nx;
            if (og + 1u == (tg + 1u) * nx) xb_add(&bar[XB_TOPGEN], 1u);
            else XB_SPIN(xb_ld(&bar[XB_TOPGEN]) == tg, bar);
            __builtin_amdgcn_fence(__ATOMIC_ACQUIRE, "agent");
            xb_add(&bar[XB_XGEN(b.x)], 1u);
            asm volatile("s_waitcnt vmcnt(0)" ::: "memory");
        } else {
            XB_SPIN(xb_ld(&bar[XB_XGEN(b.x)]) == gen, bar);
            __builtin_amdgcn_fence(__ATOMIC_ACQUIRE, "agent");
            asm volatile("s_waitcnt vmcnt(0)" ::: "memory");
        }
    }
    __syncthreads();
}

constexpr int NWAVES = 8, NTHR = 512;
constexpr int M = 32768, DM_ = 1024, SEQL = 4096, FF = 2816, NIN = 29;
constexpr float EPS = 1e-6f;
constexpr size_t MiB = 1u << 20;
constexpr size_t WS_CTL = 0, CTL_ZERO_BYTES = 65536, WS_BAR = 16384, WS_SSP = 88 * MiB;
constexpr int MISC_OFF = 131072;
constexpr size_t WS_GN = 3 * MiB;
constexpr size_t WS_CS = 1 * MiB, WS_KMAT = 2 * MiB, WS_W1T = 4 * MiB, WS_WYT = 12 * MiB;
constexpr size_t WS_WIN = 32 * MiB, WS_WOUT = 37 * MiB, WS_WGLU = 39 * MiB, WS_WQKV = 40 * MiB, WS_WO = 46 * MiB, WS_WGU = 48 * MiB, WS_WDN = 70 * MiB, WS_WPP = 81 * MiB, WS_WPG = 82 * MiB;
constexpr size_t SZ_WGU = 11 * MiB, SZ_WDN = 5632 * 1024, SZ_WPP = 512 * 1024, SZ_WPG = 2 * MiB;
constexpr size_t WS_PB = 92 * MiB, WS_HN = 124 * MiB, WS_PP = 188 * MiB, WS_MIX = 252 * MiB, WS_PROJ = 316 * MiB, WS_END = 508 * MiB;
constexpr size_t WS_Y = WS_HN, WS_OATT = WS_HN, WS_KV = WS_PP, WS_RT = WS_PP + 32 * MiB, WS_SLOC = WS_PP + 48 * MiB, WS_UX = WS_PROJ + 128 * MiB, WS_ACT = WS_PROJ;
constexpr int LDS_BYTES = 147456;
constexpr float C2Q = 0.125f * 1.4426950408889634f;

__device__ __forceinline__ unsigned f2bf(float f) { unsigned u = __builtin_bit_cast(unsigned, f); return (u + 0x7fffu + ((u >> 16) & 1u)) >> 16; }
__device__ __forceinline__ unsigned pk2(float lo, float hi) { return f2bf(lo) | (f2bf(hi) << 16); }
__device__ __forceinline__ float bflo(unsigned w) { return __uint_as_float(w << 16); }
__device__ __forceinline__ float bfhi(unsigned w) { return __uint_as_float(w & 0xffff0000u); }
__device__ __forceinline__ void rstd8(const float* ss, int row0, int fq, float (&rs)[8]) {
    f32x4 a[8];
#pragma unroll
    for (int k = 0; k < 8; ++k) a[k] = *(const f32x4*)(ss + (size_t)(row0 + (k >> 2) * 128 + (k & 3) * 16) * 16 + 4 * fq);
#pragma unroll
    for (int k = 0; k < 8; ++k) { float s = (a[k][0] + a[k][1]) + (a[k][2] + a[k][3]); s += __shfl_xor(s, 16); s += __shfl_xor(s, 32); rs[k] = __builtin_amdgcn_rsqf(s * (1.f / 1024.f) + EPS); }
}
__device__ __forceinline__ float rstd_row(const float* ss, int row) { const f32x4* p = (const f32x4*)(ss + (size_t)row * 16); const f32x4 a = p[0], b = p[1], c = p[2], d = p[3];
    const float s = (((a[0] + a[1]) + (a[2] + a[3])) + ((b[0] + b[1]) + (b[2] + b[3]))) + (((c[0] + c[1]) + (c[2] + c[3])) + ((d[0] + d[1]) + (d[2] + d[3]))); return __builtin_amdgcn_rsqf(s * (1.f / 1024.f) + EPS); }
__device__ __forceinline__ float sigm(float x) { return __builtin_amdgcn_rcpf(1.f + __expf(-x)); }
__device__ __forceinline__ float wave_sum(float v) {
#pragma unroll
    for (int o = 1; o < 64; o <<= 1) v += __shfl_xor(v, o);
    return v;
}
__device__ __forceinline__ void sincos_rad(float x, float& s, float& c) {
    double r = (double)x * 0.15915494309189535; r -= __builtin_rint(r); const float fr = (float)r;
    s = __builtin_amdgcn_sinf(fr); c = __builtin_amdgcn_cosf(fr);
}
__device__ __forceinline__ void cpow(float lr, float li, float delta, float j, float& re, float& im) {
    const float mag = expf(j * delta * lr); float s, c; sincos_rad(j * delta * li, s, c); re = mag * c; im = mag * s;
}
__device__ __forceinline__ float gelu_tanh(float v) { const float z = 1.5957691216057308f * (v + 0.044715f * v * v * v); return v * sigm(z); }

using pg8::Unit; using pg8::HALF; using pg8::BM; using pg8::cvt_pk_bf16;
template <int LAYER> struct EpiProj {
    static constexpr bool PERM = true, AFTER_DRAIN = false;
    static constexpr int ldc = LAYER ? 1024 : 2048, tps = LAYER ? 4 : (1 << 20), rope_tiles = LAYER ? 8 : 4, sc_lo = LAYER ? 0 : 2, sc_hi = 4, ux_tile = LAYER ? (1 << 30) : 8;
    static constexpr size_t sstride = (size_t)M * 1024; static constexpr float sc = LAYER ? C2Q : 0.125f;
    bf16* O; const float* cs; bf16* UX; const float* ss;
    __device__ __forceinline__ void operator()(const pg8::f32x4 (&acc)[2][2][4][2], const Unit& u, int wr, int wc, int fr, int fq) const {
        const int pn = u.pn; const int row0 = u.pm * BM + wr * 64 + fr; const int sp = pn / tps, pt = pn - sp * tps; bf16* const Ob = O + (size_t)sp * sstride;
        float rsv[8]; rstd8(ss, row0, fq, rsv);
        if (pn < rope_tiles) {
            const float s_ = (pn >= sc_lo && pn < sc_hi) ? sc : 1.f;
            const int i0 = 16 * (wc & 1) + 4 * fq;
            f32x4 cN = *(const f32x4*)(cs + (row0 & (SEQL - 1)) * 64 + i0), sN = *(const f32x4*)(cs + (row0 & (SEQL - 1)) * 64 + 32 + i0);
#pragma unroll
            for (int k = 0; k < 8; ++k) { const int ai = k >> 2, m = k & 3; const int row = row0 + ai * HALF + m * 16; const float s = s_ * rsv[k];
                const f32x4 c = cN, sn = sN;
                if (k < 7) { const int rown = row0 + ((k + 1) >> 2) * HALF + ((k + 1) & 3) * 16, posn = rown & (SEQL - 1); cN = *(const f32x4*)(cs + posn * 64 + i0); sN = *(const f32x4*)(cs + posn * 64 + 32 + i0); }
#pragma unroll
                for (int bj = 0; bj < 2; ++bj) { const f32x4 x1 = acc[ai][bj][m][0], x2 = acc[ai][bj][m][1];
                    const f32x4 o1 = (x1 * c - x2 * sn) * s, o2 = (x2 * c + x1 * sn) * s;
                    bf16* p = Ob + (size_t)row * ldc + pt * BM + bj * HALF + 64 * (wc >> 1) + i0;
                    v2u w1, w2; w1.x = cvt_pk_bf16(o1[0], o1[1]); w1.y = cvt_pk_bf16(o1[2], o1[3]); w2.x = cvt_pk_bf16(o2[0], o2[1]); w2.y = cvt_pk_bf16(o2[2], o2[3]);
                    *(v2u*)p = w1; *(v2u*)(p + 32) = w2; } }
        } else if (pn < ux_tile) {
#pragma unroll
            for (int ai = 0; ai < 2; ++ai)
#pragma unroll
                for (int m = 0; m < 4; ++m) { const int row = row0 + ai * HALF + m * 16; const float rs = rsv[ai * 4 + m];
#pragma unroll
                    for (int bj = 0; bj < 2; ++bj) { const f32x4 v0 = acc[ai][bj][m][0] * rs, v1 = acc[ai][bj][m][1] * rs;
                        v4u w; w.x = cvt_pk_bf16(v0[0], v0[1]); w.y = cvt_pk_bf16(v0[2], v0[3]); w.z = cvt_pk_bf16(v1[0], v1[1]); w.w = cvt_pk_bf16(v1[2], v1[3]);
                        __builtin_nontemporal_store(w, (v4u*)(Ob + (size_t)row * ldc + pt * BM + bj * HALF + wc * 32 + 8 * fq)); } }
        } else {
#pragma unroll
            for (int ai = 0; ai < 2; ++ai)
#pragma unroll
                for (int m = 0; m < 4; ++m) { const int row = row0 + ai * HALF + m * 16; const float rs = rsv[ai * 4 + m];
#pragma unroll
                    for (int bj = 0; bj < 2; ++bj) { const f32x4 v0 = acc[ai][bj][m][0] * rs, v1 = acc[ai][bj][m][1] * rs;
                        v4u w; w.x = cvt_pk_bf16(v0[0], v0[1]); w.y = cvt_pk_bf16(v0[2], v0[3]); w.z = cvt_pk_bf16(v1[0], v1[1]); w.w = cvt_pk_bf16(v1[2], v1[3]);
                        const int ch = (pn - ux_tile) * BM + bj * HALF + wc * 32 + 8 * fq, g = ch >> 4, c0 = ch & 15;
                        __builtin_nontemporal_store(w, (v4u*)(UX + ((size_t)g * 1024 + (row >> 5)) * 640 + (row & 31) * 16 + c0)); } }
        }
    }
};
struct EpiPlain {
    static constexpr bool PERM = true, AFTER_DRAIN = false;
    bf16* O;
    __device__ __forceinline__ void operator()(const pg8::f32x4 (&acc)[2][2][4][2], const Unit& u, int wr, int wc, int fr, int fq) const {
        const int row0 = u.pm * BM + wr * 64 + fr, col0 = u.pn * BM + wc * 32 + 8 * fq;
#pragma unroll
        for (int ai = 0; ai < 2; ++ai)
#pragma unroll
            for (int m = 0; m < 4; ++m)
#pragma unroll
                for (int bj = 0; bj < 2; ++bj) { const pg8::f32x4 v0 = acc[ai][bj][m][0], v1 = acc[ai][bj][m][1];
                    v4u w; w.x = cvt_pk_bf16(v0[0], v0[1]); w.y = cvt_pk_bf16(v0[2], v0[3]); w.z = cvt_pk_bf16(v1[0], v1[1]); w.w = cvt_pk_bf16(v1[2], v1[3]);
                    *(v4u*)(O + (size_t)(row0 + ai * HALF + m * 16) * DM_ + col0 + bj * HALF) = w; }
    }
};
template <bool BASEF32> struct EpiRes {
    static constexpr bool PERM = true, AFTER_DRAIN = false;
    const void* base; bf16* out; float* ssq;
    struct Ld { f32x4 a[2][2]; };
    __device__ __forceinline__ void ld(Ld& L, size_t o) const {
#pragma unroll
        for (int bj = 0; bj < 2; ++bj) { if (BASEF32) { L.a[bj][0] = *(const f32x4*)((const float*)base + o + bj * HALF); L.a[bj][1] = *(const f32x4*)((const float*)base + o + bj * HALF + 4); }
            else { const v4u w = *(const v4u*)((const bf16*)base + o + bj * HALF); L.a[bj][0] = __builtin_bit_cast(f32x4, w); } }
    }
    __device__ __forceinline__ void operator()(const pg8::f32x4 (&acc)[2][2][4][2], const Unit& u, int wr, int wc, int fr, int fq) const {
        const int row0 = u.pm * BM + wr * 64 + fr, col0 = u.pn * BM + wc * 32 + 8 * fq;
        Ld nx; ld(nx, (size_t)row0 * DM_ + col0);
#pragma unroll
        for (int k = 0; k < 8; ++k) { const int ai = k >> 2, m = k & 3; const int row = row0 + ai * HALF + m * 16; float q = 0.f; const Ld cu = nx;
            if (k < 7) ld(nx, (size_t)(row0 + ((k + 1) >> 2) * HALF + ((k + 1) & 3) * 16) * DM_ + col0);
#pragma unroll
            for (int bj = 0; bj < 2; ++bj) { const size_t o = (size_t)row * DM_ + col0 + bj * HALF; f32x4 b0, b1;
                if (BASEF32) { b0 = cu.a[bj][0]; b1 = cu.a[bj][1]; }
                else { const v4u w = __builtin_bit_cast(v4u, cu.a[bj][0]); b0 = (f32x4){bflo(w.x), bfhi(w.x), bflo(w.y), bfhi(w.y)}; b1 = (f32x4){bflo(w.z), bfhi(w.z), bflo(w.w), bfhi(w.w)}; }
                const f32x4 r0 = b0 + acc[ai][bj][m][0], r1 = b1 + acc[ai][bj][m][1];
                q += (r0[0] * r0[0] + r0[1] * r0[1]) + (r0[2] * r0[2] + r0[3] * r0[3]) + (r1[0] * r1[0] + r1[1] * r1[1]) + (r1[2] * r1[2] + r1[3] * r1[3]);
                v4u w; w.x = cvt_pk_bf16(r0[0], r0[1]); w.y = cvt_pk_bf16(r0[2], r0[3]); w.z = cvt_pk_bf16(r1[0], r1[1]); w.w = cvt_pk_bf16(r1[2], r1[3]); *(v4u*)(out + o) = w; }
            q += __shfl_xor(q, 16); q += __shfl_xor(q, 32); if (fq == 0) ssq[(size_t)row * 16 + u.pn * 4 + wc] = q; }
    }
};
struct EpiPle {
    static constexpr bool PERM = true, AFTER_DRAIN = false;
    const bf16* pp; const bf16* base; const float* ss; bf16* out; float* ssq;
    __device__ __forceinline__ void operator()(const pg8::f32x4 (&acc)[2][2][4][2], const Unit& u, int wr, int wc, int fr, int fq) const {
        const int row0 = u.pm * BM + wr * 64 + fr, col0 = u.pn * BM + wc * 32 + 8 * fq;
        float rsv[8]; rstd8(ss, row0, fq, rsv);
        v4u nb[2], np[2];
#pragma unroll
        for (int bj = 0; bj < 2; ++bj) { const size_t o = (size_t)row0 * DM_ + col0 + bj * HALF; nb[bj] = *(const v4u*)(base + o); np[bj] = *(const v4u*)(pp + o); }
#pragma unroll
        for (int k = 0; k < 8; ++k) { const int ai = k >> 2, m = k & 3; const int row = row0 + ai * HALF + m * 16; const float rs = rsv[k]; float q = 0.f;
            v4u cb[2], cp[2];
#pragma unroll
            for (int bj = 0; bj < 2; ++bj) { cb[bj] = nb[bj]; cp[bj] = np[bj]; }
            if (k < 7) {
#pragma unroll
                for (int bj = 0; bj < 2; ++bj) { const size_t o = (size_t)(row0 + ((k + 1) >> 2) * HALF + ((k + 1) & 3) * 16) * DM_ + col0 + bj * HALF; nb[bj] = *(const v4u*)(base + o); np[bj] = *(const v4u*)(pp + o); } }
#pragma unroll
            for (int bj = 0; bj < 2; ++bj) { const size_t o = (size_t)row * DM_ + col0 + bj * HALF; const v4u bw = cb[bj], pw = cp[bj];
                const float c1 = -1.4426950408889634f * rs; float r[8];
#define PLE2(kk, A, e0, BW, PW) { const f32x2 t = (f32x2){A[e0], A[e0 + 1]} * c1; f32x2 d; d.x = __builtin_amdgcn_exp2f(t.x); d.y = __builtin_amdgcn_exp2f(t.y); d = d + 1.0f; \
                    f32x2 q2; q2.x = __builtin_amdgcn_rcpf(d.x); q2.y = __builtin_amdgcn_rcpf(d.y); const f32x2 o2 = (f32x2){bflo(BW), bfhi(BW)} + (f32x2){bflo(PW), bfhi(PW)} * q2; r[kk] = o2.x; r[kk + 1] = o2.y; }
                { const f32x4 a0 = acc[ai][bj][m][0], a1 = acc[ai][bj][m][1];
                  PLE2(0, a0, 0, bw.x, pw.x) PLE2(2, a0, 2, bw.y, pw.y) PLE2(4, a1, 0, bw.z, pw.z) PLE2(6, a1, 2, bw.w, pw.w) }
#undef PLE2
#pragma unroll
                for (int e = 0; e < 8; ++e) q += r[e] * r[e];
                v4u w; w.x = cvt_pk_bf16(r[0], r[1]); w.y = cvt_pk_bf16(r[2], r[3]); w.z = cvt_pk_bf16(r[4], r[5]); w.w = cvt_pk_bf16(r[6], r[7]); *(v4u*)(out + o) = w; }
            q += __shfl_xor(q, 16); q += __shfl_xor(q, 32); if (fq == 0) ssq[(size_t)row * 16 + u.pn * 4 + wc] = q; }
    }
};
struct EpiSwiglu {
    static constexpr bool PERM = true, AFTER_DRAIN = false;
    bf16* O; const float* ss;
    __device__ __forceinline__ void operator()(const pg8::f32x4 (&acc)[2][2][4][2], const Unit& u, int wr, int wc, int fr, int fq) const {
        const int row0 = u.pm * BM + wr * 64 + fr, col0 = u.pn * HALF + wc * 32 + 8 * fq;
        float rsv[8]; rstd8(ss, row0, fq, rsv);
#pragma unroll
        for (int ai = 0; ai < 2; ++ai)
#pragma unroll
            for (int m = 0; m < 4; ++m) { float r[8]; const float rs = rsv[ai * 4 + m]; const float c1 = -1.4426950408889634f * rs, rs2 = rs * rs;
#pragma unroll
                for (int n = 0; n < 2; ++n)
#pragma unroll
                    for (int e = 0; e < 4; e += 2) { const f32x2 ag = {acc[ai][0][m][n][e], acc[ai][0][m][n][e + 1]}, au = {acc[ai][1][m][n][e], acc[ai][1][m][n][e + 1]};
                        const f32x2 t = ag * c1; f32x2 d; d.x = __builtin_amdgcn_exp2f(t.x); d.y = __builtin_amdgcn_exp2f(t.y); d = d + 1.0f;
                        f32x2 q; q.x = __builtin_amdgcn_rcpf(d.x); q.y = __builtin_amdgcn_rcpf(d.y); const f32x2 o = (ag * au) * rs2 * q; r[4 * n + e] = o.x; r[4 * n + e + 1] = o.y; }
                v4u w; w.x = cvt_pk_bf16(r[0], r[1]); w.y = cvt_pk_bf16(r[2], r[3]); w.z = cvt_pk_bf16(r[4], r[5]); w.w = cvt_pk_bf16(r[6], r[7]);
                __builtin_nontemporal_store(w, (v4u*)(O + (size_t)(row0 + ai * HALF + m * 16) * FF + col0)); }
    }
};
struct EpiGlu {
    static constexpr bool PERM = true, AFTER_DRAIN = false;
    const bf16* Y; bf16* O;
    __device__ __forceinline__ void operator()(const pg8::f32x4 (&acc)[2][2][4][2], const Unit& u, int wr, int wc, int fr, int fq) const {
        const int row0 = u.pm * BM + wr * 64 + fr, col0 = u.pn * BM + wc * 32 + 8 * fq;
        v4u ny[2];
#pragma unroll
        for (int bj = 0; bj < 2; ++bj) ny[bj] = *(const v4u*)(Y + (size_t)row0 * 512 + col0 + bj * HALF);
#pragma unroll
        for (int k = 0; k < 8; ++k) { const int ai = k >> 2, m = k & 3; const int row = row0 + ai * HALF + m * 16; v4u cy[2];
#pragma unroll
            for (int bj = 0; bj < 2; ++bj) cy[bj] = ny[bj];
            if (k < 7) {
#pragma unroll
                for (int bj = 0; bj < 2; ++bj) ny[bj] = *(const v4u*)(Y + (size_t)(row0 + ((k + 1) >> 2) * HALF + ((k + 1) & 3) * 16) * 512 + col0 + bj * HALF); }
#pragma unroll
            for (int bj = 0; bj < 2; ++bj) { const int col = col0 + bj * HALF; const v4u yw = cy[bj]; const f32x4 a0 = acc[ai][bj][m][0], a1 = acc[ai][bj][m][1];
                v4u w; w.x = cvt_pk_bf16(bflo(yw.x) * sigm(a0[0]), bfhi(yw.x) * sigm(a0[1])); w.y = cvt_pk_bf16(bflo(yw.y) * sigm(a0[2]), bfhi(yw.y) * sigm(a0[3]));
                w.z = cvt_pk_bf16(bflo(yw.z) * sigm(a1[0]), bfhi(yw.z) * sigm(a1[1])); w.w = cvt_pk_bf16(bflo(yw.w) * sigm(a1[2]), bfhi(yw.w) * sigm(a1[3]));
                *(v4u*)(O + (size_t)row * DM_ + 512 + col) = w; } }
    }
};
struct EpiSloc {
    static constexpr bool PERM = false, AFTER_DRAIN = false;
    float* S;
    __device__ __forceinline__ void operator()(const pg8::f32x4 (&acc)[2][2][4][2], const Unit& u, int wr, int wc, int fr, int fq) const {
        const int row0 = u.pm * BM + wr * 64 + fr, col0 = wc * 32 + 4 * fq;
#pragma unroll
        for (int ai = 0; ai < 2; ++ai)
#pragma unroll
            for (int m = 0; m < 4; ++m) { float* p = S + ((size_t)u.g * 1024 + row0 + ai * HALF + m * 16) * 128 + col0;
#pragma unroll
                for (int n = 0; n < 2; ++n) *(f32x4*)(p + n * 16) = acc[ai][0][m][n]; }
    }
};
struct EpiS5Y {
    static constexpr bool PERM = true, AFTER_DRAIN = false;
    const bf16* UX; bf16* Y; const float* dsk;
    __device__ __forceinline__ void operator()(const pg8::f32x4 (&acc)[2][2][4][2], const Unit& u, int wr, int wc, int fr, int fq) const {
        const int row0 = u.pm * BM + wr * 64 + fr; const int c0 = 8 * (fq & 1);
        const f32x4 d0 = *(const f32x4*)(dsk + u.g * 16 + c0), d1 = *(const f32x4*)(dsk + u.g * 16 + c0 + 4);
        const int colb = u.pn * BM + wc * 32 + 8 * fq;
        v4u nu[2];
#pragma unroll
        for (int bj = 0; bj < 2; ++bj) nu[bj] = *(const v4u*)(UX + ((size_t)u.g * 1024 + row0) * 640 + ((colb + bj * HALF) >> 4) * 16 + c0);
#pragma unroll
        for (int k = 0; k < 8; ++k) { const int ai = k >> 2, m = k & 3; const int row = row0 + ai * HALF + m * 16; v4u cu[2];
#pragma unroll
            for (int bj = 0; bj < 2; ++bj) cu[bj] = nu[bj];
            if (k < 7) {
#pragma unroll
                for (int bj = 0; bj < 2; ++bj) nu[bj] = *(const v4u*)(UX + ((size_t)u.g * 1024 + row0 + ((k + 1) >> 2) * HALF + ((k + 1) & 3) * 16) * 640 + ((colb + bj * HALF) >> 4) * 16 + c0); }
#pragma unroll
            for (int bj = 0; bj < 2; ++bj) { const int tau = (colb + bj * HALF) >> 4;
                const v4u uw = cu[bj]; const f32x4 a0 = acc[ai][bj][m][0], a1 = acc[ai][bj][m][1];
                float r[8]; r[0] = a0[0] + d0[0] * bflo(uw.x); r[1] = a0[1] + d0[1] * bfhi(uw.x); r[2] = a0[2] + d0[2] * bflo(uw.y); r[3] = a0[3] + d0[3] * bfhi(uw.y);
                r[4] = a1[0] + d1[0] * bflo(uw.z); r[5] = a1[1] + d1[1] * bfhi(uw.z); r[6] = a1[2] + d1[2] * bflo(uw.w); r[7] = a1[3] + d1[3] * bfhi(uw.w);
#pragma unroll
                for (int e = 0; e < 8; ++e) r[e] = gelu_tanh(r[e]);
                v4u w; w.x = cvt_pk_bf16(r[0], r[1]); w.y = cvt_pk_bf16(r[2], r[3]); w.z = cvt_pk_bf16(r[4], r[5]); w.w = cvt_pk_bf16(r[6], r[7]);
                *(v4u*)(Y + ((size_t)row * 32 + tau) * 512 + u.g * 16 + c0) = w; } }
    }
};
struct GroupOrder {
    int nM, nN, ng, G, c;
    __device__ __forceinline__ bool next(int i, Unit& u) const { const int L = i * G + c; if (L >= nM * nN * ng) return false; const int per = nM * nN, r = L % per; u.g = L / per; u.pn = r / nM; u.pm = r % nM; return true; }
    __device__ __forceinline__ void a_ready(const Unit&) const {}
    __device__ __forceinline__ void done(const Unit&) const {}
};

struct Frame { LAS unsigned char* lds; int tid, lane, wave, G, bx, gw, NGW; };

__device__ __forceinline__ int maprow(int mode, int lim, int n) {
    if (mode == 1) { if (n >= lim) return n; const int i = n & 63, ii = i & 31; return (n & ~63) + 32 * (ii >> 4) + 8 * ((ii >> 2) & 3) + 4 * (i >> 5) + (ii & 3); }
    if (mode == 2) return 256 * (n >> 7) + (n & 127);
    if (mode == 3) return 256 * (n >> 7) + 128 + (n & 127);
    return n;
}
template <bool HAS_GAIN> __device__ __forceinline__ void transpose_item(const float* W, int K, int N, bf16* WT, int mode, int lim, LAS float* scr, int item, int lane, const float* gain) {
    const int nblk = N / 32, kb = item / nblk, nb = item % nblk, k0 = 64 * kb, n0 = 32 * nb;
    const float* src = W + (size_t)(k0 + (lane >> 5)) * N + n0 + (lane & 31);
    float v[32];
#pragma unroll
    for (int i = 0; i < 32; ++i) v[i] = __builtin_nontemporal_load(src + (size_t)(2 * i) * N);
    const int c = lane & 7;
    f32x4 ga = {1.f, 1.f, 1.f, 1.f}, gb = {1.f, 1.f, 1.f, 1.f};
    if (HAS_GAIN) { ga = *(const f32x4*)(gain + k0 + 8 * c); gb = *(const f32x4*)(gain + k0 + 8 * c + 4); }
#pragma unroll
    for (int i = 0; i < 32; ++i) scr[(2 * i + (lane >> 5)) * 33 + (lane & 31)] = v[i];
    asm volatile("s_waitcnt lgkmcnt(0)" ::: "memory");
#pragma unroll
    for (int j = 0; j < 4; ++j) { const int n = (lane >> 3) + 8 * j; const LAS float* s = scr + (8 * c) * 33 + n;
        v4u o; o.x = pk2(s[0 * 33] * ga[0], s[1 * 33] * ga[1]); o.y = pk2(s[2 * 33] * ga[2], s[3 * 33] * ga[3]); o.z = pk2(s[4 * 33] * gb[0], s[5 * 33] * gb[1]); o.w = pk2(s[6 * 33] * gb[2], s[7 * 33] * gb[3]);
        *(v4u*)(WT + (size_t)maprow(mode, lim, n0 + n) * K + k0 + 8 * c) = o; }
    asm volatile("s_waitcnt lgkmcnt(0)" ::: "memory");
}
__device__ __forceinline__ void final_norm_phase(const Frame& F, const bf16* h, const float* ssq, const float* gain, float* out) {
    for (int it = F.bx * NTHR + F.tid; it < M * 128; it += F.G * NTHR) { const int row = it >> 7, c8 = (it & 127) * 8; const float rs = rstd_row(ssq, row);
        const v4u w = *(const v4u*)(h + (size_t)row * DM_ + c8); const f32x4 g0 = *(const f32x4*)(gain + c8), g1 = *(const f32x4*)(gain + c8 + 4);
        float* o = out + (size_t)row * DM_ + c8;
        __builtin_nontemporal_store((f32x4){bflo(w.x) * rs * g0[0], bfhi(w.x) * rs * g0[1], bflo(w.y) * rs * g0[2], bfhi(w.y) * rs * g0[3]}, (f32x4*)o);
        __builtin_nontemporal_store((f32x4){bflo(w.z) * rs * g1[0], bfhi(w.z) * rs * g1[1], bflo(w.w) * rs * g1[2], bfhi(w.w) * rs * g1[3]}, (f32x4*)(o + 4)); }
}
__device__ __forceinline__ float ret_log2g(int h) { return log1pf(-exp2f(-5.f - (float)h)) * 1.4426950408889634f; }
constexpr int VT_LD = 136;
__device__ __forceinline__ void ret_kv_phase(const Frame& F, const bf16* P0, float* KV) {
    LAS bf16* Vt = (LAS bf16*)F.lds; LAS bf16* Kt = Vt + 64 * VT_LD;
    const int fr = F.lane & 15, fq = F.lane >> 4; const int s = F.tid >> 2, part = F.tid & 3;
    v4u pv0, pv1, pk0, pk1;
#define KV_PREFETCH(uu) { const int n_ = (uu) & 31, bh_ = (uu) >> 5, h_ = bh_ & 7, b_ = bh_ >> 3; const bf16* src = P0 + (size_t)(b_ * SEQL + n_ * 128 + s) * 2048 + 64 * h_ + 16 * part; \
        pv0 = *(const v4u*)(src + 1024); pv1 = *(const v4u*)(src + 1032); pk0 = *(const v4u*)(src + 512); pk1 = *(const v4u*)(src + 520); }
    int u = F.bx; if (u < 2048) KV_PREFETCH(u);
    for (; u < 2048; u += F.G) { const int h = (u >> 5) & 7; const float lg = ret_log2g(h);
        __syncthreads();
        { LAS bf16* vd = Vt + (16 * part) * VT_LD + s; LAS bf16* kd = Kt + (16 * part) * VT_LD + s; const float z = exp2f((float)(127 - s) * lg);
#define PUT(k, w) vd[(k) * VT_LD] = (bf16)((w) & 0xffffu); vd[((k) + 1) * VT_LD] = (bf16)((w) >> 16)
#define PUTK(k, w) kd[(k) * VT_LD] = (bf16)f2bf(bflo(w) * z); kd[((k) + 1) * VT_LD] = (bf16)f2bf(bfhi(w) * z)
          PUT(0, pv0.x); PUT(2, pv0.y); PUT(4, pv0.z); PUT(6, pv0.w); PUT(8, pv1.x); PUT(10, pv1.y); PUT(12, pv1.z); PUT(14, pv1.w);
          PUTK(0, pk0.x); PUTK(2, pk0.y); PUTK(4, pk0.z); PUTK(6, pk0.w); PUTK(8, pk1.x); PUTK(10, pk1.y); PUTK(12, pk1.z); PUTK(14, pk1.w);
#undef PUT
#undef PUTK
        }
        __syncthreads();
        if (u + F.G < 2048) KV_PREFETCH(u + F.G);
#pragma unroll
        for (int t2 = 0; t2 < 2; ++t2) { const int id = 2 * F.wave + t2, et = id >> 2, dt = id & 3; pg8::f32x4 acc = {0.f, 0.f, 0.f, 0.f};
#pragma unroll
            for (int sk = 0; sk < 4; ++sk) { const bf16x8 a = *(const LAS bf16x8*)(Vt + (16 * et + fr) * VT_LD + 32 * sk + 8 * fq), bb = *(const LAS bf16x8*)(Kt + (16 * dt + fr) * VT_LD + 32 * sk + 8 * fq);
                acc = __builtin_amdgcn_mfma_f32_16x16x32_bf16(a, bb, acc, 0, 0, 0); }
            float* o = KV + (size_t)u * 4096 + (16 * et + 4 * fq) * 64 + 16 * dt + fr;
#pragma unroll
            for (int j = 0; j < 4; ++j) o[j * 64] = acc[j]; }
    }
#undef KV_PREFETCH
    __syncthreads();
}
__device__ __forceinline__ void ret_scan_phase(const Frame& F, const float* KV, bf16* RT) {
    for (int idx = F.bx * NTHR + F.tid; idx < 64 * 4096; idx += F.G * NTHR) { const int bh = idx >> 12, el = idx & 4095, h = bh & 7; const float cd = exp2f(128.f * ret_log2g(h));
        float r = 0.f; const float* kv = KV + (size_t)bh * 32 * 4096 + el; bf16* rt = RT + (size_t)bh * 32 * 4096 + el; float k[32];
#pragma unroll
        for (int n = 0; n < 32; ++n) k[n] = kv[(size_t)n * 4096];
#pragma unroll
        for (int n = 0; n < 32; ++n) { rt[(size_t)n * 4096] = (bf16)f2bf(r); r = cd * r + k[n]; } }
}
constexpr int QK_LD = 72;
__device__ __forceinline__ void ret_out_phase(const Frame& F, const bf16* P0, const bf16* RT, bf16* MIX) {
    LAS bf16* Vt = (LAS bf16*)F.lds; LAS bf16* Qs = Vt + 64 * VT_LD; LAS bf16* Ks = Qs + 128 * QK_LD; LAS bf16* Rs = Ks + 128 * QK_LD;
    const int fr = F.lane & 15, fq = F.lane >> 4, w = F.wave;
    const int srow0 = F.tid >> 3, sch = F.tid & 7;
    v4u pq[2], pk[2], pv[2], pr;
#define RET_PREFETCH(uu) { const int n_ = (uu) & 31, bh_ = (uu) >> 5, h_ = bh_ & 7, b_ = bh_ >> 3; const bf16* s_ = P0 + (size_t)(b_ * SEQL + n_ * 128 + srow0) * 2048 + 64 * h_ + 8 * sch; \
        pq[0] = *(const v4u*)s_; pk[0] = *(const v4u*)(s_ + 512); pv[0] = *(const v4u*)(s_ + 1024); \
        pq[1] = *(const v4u*)(s_ + 64 * 2048); pk[1] = *(const v4u*)(s_ + 64 * 2048 + 512); pv[1] = *(const v4u*)(s_ + 64 * 2048 + 1024); \
        pr = *(const v4u*)(RT + (size_t)(uu) * 4096 + F.tid * 8); }
    int u = F.bx; if (u < 2048) RET_PREFETCH(u);
    for (; u < 2048; u += F.G) { const int n = u & 31, bh = u >> 5, h = bh & 7, b = bh >> 3; const float lg = ret_log2g(h); const int rowbase = b * SEQL + n * 128;
        __syncthreads();
#pragma unroll
        for (int i = 0; i < 2; ++i) { const int row = srow0 + 64 * i; *(LAS v4u*)(Qs + row * QK_LD + 8 * sch) = pq[i]; *(LAS v4u*)(Ks + row * QK_LD + 8 * sch) = pk[i];
            LAS bf16* vd = Vt + (8 * sch) * VT_LD + row; const v4u v = pv[i];
            vd[0 * VT_LD] = (bf16)(v.x & 0xffffu); vd[1 * VT_LD] = (bf16)(v.x >> 16); vd[2 * VT_LD] = (bf16)(v.y & 0xffffu); vd[3 * VT_LD] = (bf16)(v.y >> 16);
            vd[4 * VT_LD] = (bf16)(v.z & 0xffffu); vd[5 * VT_LD] = (bf16)(v.z >> 16); vd[6 * VT_LD] = (bf16)(v.w & 0xffffu); vd[7 * VT_LD] = (bf16)(v.w >> 16); }
        *(LAS v4u*)(Rs + srow0 * QK_LD + 8 * sch) = pr;
        const int t = 16 * w + fr; v2u gwv[4];
        { const bf16* gp = P0 + (size_t)(rowbase + t) * 2048 + 1536 + 64 * h + 4 * fq;
#pragma unroll
          for (int et = 0; et < 4; ++et) gwv[et] = *(const v2u*)(gp + 16 * et); }
        __syncthreads();
        if (u + F.G < 2048) RET_PREFETCH(u + F.G);
        const bf16x8 q0 = *(const LAS bf16x8*)(Qs + t * QK_LD + 8 * fq), q1 = *(const LAS bf16x8*)(Qs + t * QK_LD + 8 * fq + 32);
        pg8::f32x4 ao[4], ai[4];
#pragma unroll
        for (int et = 0; et < 4; ++et) { ao[et] = (pg8::f32x4){0.f, 0.f, 0.f, 0.f}; ai[et] = (pg8::f32x4){0.f, 0.f, 0.f, 0.f}; }
#pragma unroll
        for (int c32 = 0; c32 < 4; ++c32) { if (c32 <= (w >> 1)) {
            const LAS bf16* kp = Ks + (32 * c32 + fr) * QK_LD + 8 * fq;
            const bf16x8 kA0 = *(const LAS bf16x8*)kp, kA1 = *(const LAS bf16x8*)(kp + 32), kB0 = *(const LAS bf16x8*)(kp + 16 * QK_LD), kB1 = *(const LAS bf16x8*)(kp + 16 * QK_LD + 32);
            pg8::f32x4 s0 = {0.f, 0.f, 0.f, 0.f}, s1 = {0.f, 0.f, 0.f, 0.f};
            s0 = __builtin_amdgcn_mfma_f32_16x16x32_bf16(kA0, q0, s0, 0, 0, 0); s0 = __builtin_amdgcn_mfma_f32_16x16x32_bf16(kA1, q1, s0, 0, 0, 0);
            s1 = __builtin_amdgcn_mfma_f32_16x16x32_bf16(kB0, q0, s1, 0, 0, 0); s1 = __builtin_amdgcn_mfma_f32_16x16x32_bf16(kB1, q1, s1, 0, 0, 0);
            float pvv[8];
#pragma unroll
            for (int j = 0; j < 4; ++j) { const int sA = 32 * c32 + 4 * fq + j, rA = t - sA, rB = rA - 16;
                pvv[j] = rA >= 0 ? s0[j] * exp2f((float)rA * lg) : 0.f; pvv[4 + j] = rB >= 0 ? s1[j] * exp2f((float)rB * lg) : 0.f; }
            v4u pw; pw.x = pk2(pvv[0], pvv[1]); pw.y = pk2(pvv[2], pvv[3]); pw.z = pk2(pvv[4], pvv[5]); pw.w = pk2(pvv[6], pvv[7]);
            const bf16x8 pb = __builtin_bit_cast(bf16x8, pw);
#pragma unroll
            for (int et = 0; et < 4; ++et) { const LAS bf16* vp = Vt + (16 * et + fr) * VT_LD + 32 * c32 + 4 * fq; const v2u lo = *(const LAS v2u*)vp, hi = *(const LAS v2u*)(vp + 16);
                v4u aw; aw.x = lo.x; aw.y = lo.y; aw.z = hi.x; aw.w = hi.y;
                ao[et] = __builtin_amdgcn_mfma_f32_16x16x32_bf16(__builtin_bit_cast(bf16x8, aw), pb, ao[et], 0, 0, 0); }
        } }
#pragma unroll
        for (int et = 0; et < 4; ++et) { const LAS bf16* rp = Rs + (16 * et + fr) * QK_LD + 8 * fq; const bf16x8 r0 = *(const LAS bf16x8*)rp, r1 = *(const LAS bf16x8*)(rp + 32);
            ai[et] = __builtin_amdgcn_mfma_f32_16x16x32_bf16(r0, q0, ai[et], 0, 0, 0); ai[et] = __builtin_amdgcn_mfma_f32_16x16x32_bf16(r1, q1, ai[et], 0, 0, 0); }
        const float xi = exp2f((float)(t + 1) * lg);
        float sum = 0.f;
#pragma unroll
        for (int et = 0; et < 4; ++et) { ao[et] = ao[et] + ai[et] * xi; sum += (ao[et][0] + ao[et][1]) + (ao[et][2] + ao[et][3]); }
        sum += __shfl_xor(sum, 16); sum += __shfl_xor(sum, 32);
        const float mean = sum * (1.f / 64.f); float var = 0.f;
#pragma unroll
        for (int et = 0; et < 4; ++et) { ao[et] = ao[et] - mean; var += (ao[et][0] * ao[et][0] + ao[et][1] * ao[et][1]) + (ao[et][2] * ao[et][2] + ao[et][3] * ao[et][3]); }
        var += __shfl_xor(var, 16); var += __shfl_xor(var, 32);
        const float rstd = 1.f / sqrtf(var * (1.f / 64.f) + EPS);
        bf16* op = MIX + (size_t)(rowbase + t) * DM_ + 64 * h + 4 * fq;
#pragma unroll
        for (int et = 0; et < 4; ++et) { const v2u gw = gwv[et]; const float g0 = bflo(gw.x), g1 = bfhi(gw.x), g2 = bflo(gw.y), g3 = bfhi(gw.y);
            v2u ow; ow.x = pk2(g0 * sigm(g0) * ao[et][0] * rstd, g1 * sigm(g1) * ao[et][1] * rstd); ow.y = pk2(g2 * sigm(g2) * ao[et][2] * rstd, g3 * sigm(g3) * ao[et][3] * rstd);
            *(v2u*)(op + 16 * et) = ow; }
    }
#undef RET_PREFETCH
    __syncthreads();
}

struct S5P { const float *lre, *lim, *bre, *bim, *cre, *cim, *dsk, *lstep; };
__device__ __forceinline__ void s5_coef(float lr, float li, float delta, float& cr, float& ci) {
    float br, bi; cpow(lr, li, delta, 1.f, br, bi); const float a = br - 1.f, den = 1.f / (lr * lr + li * li); cr = (a * lr + bi * li) * den; ci = (bi * lr - a * li) * den;
}
__device__ __forceinline__ void s5_build(const Frame& F, const S5P& P, bf16* W1T, bf16* WYT, float* KMAT) {
    const int it0 = F.gw * 64 + F.lane, NT = F.NGW * 64;
    for (int it = F.gw; it < 32 * 32; it += F.NGW) { const int g = it >> 5, j = it & 31; const float delta = expf(P.lstep[g]);
        const float lr = P.lre[g * 64 + F.lane], li = P.lim[g * 64 + F.lane]; float pr, pi, cr, ci; cpow(lr, li, delta, (float)j, pr, pi); s5_coef(lr, li, delta, cr, ci);
        const float zr = pr * cr - pi * ci, zi = pr * ci + pi * cr; const int cp = F.lane >> 2, c4 = 4 * (F.lane & 3);
        f32x4 acc = {0.f, 0.f, 0.f, 0.f};
#pragma unroll 8
        for (int p = 0; p < 64; ++p) { const float zrp = __shfl(zr, p), zip = __shfl(zi, p); const float c_r = P.cre[(g * 16 + cp) * 64 + p], c_i = P.cim[(g * 16 + cp) * 64 + p];
            const float wr_ = c_r * zrp - c_i * zip, wi_ = c_r * zip + c_i * zrp;
            const f32x4 b_r = *(const f32x4*)(P.bre + (size_t)(g * 64 + p) * 16 + c4), b_i = *(const f32x4*)(P.bim + (size_t)(g * 64 + p) * 16 + c4);
            acc = acc + b_r * wr_ - b_i * wi_; }
        *(f32x4*)(KMAT + ((size_t)((g * 32 + j) * 16 + cp)) * 16 + c4) = acc; }
    for (int it = it0; it < 32 * 64 * 32; it += NT) { const int sg = it & 31, p = (it >> 5) & 63, g = it >> 11; const float delta = expf(P.lstep[g]); const float lr = P.lre[g * 64 + p], li = P.lim[g * 64 + p];
        float pr, pi, cr, ci; cpow(lr, li, delta, (float)(31 - sg), pr, pi); s5_coef(lr, li, delta, cr, ci); const float zr = pr * cr - pi * ci, zi = pr * ci + pi * cr;
        const float* brp = P.bre + (size_t)(g * 64 + p) * 16; const float* bip = P.bim + (size_t)(g * 64 + p) * 16; float re[16], im[16];
#pragma unroll
        for (int c = 0; c < 16; ++c) { re[c] = zr * brp[c] - zi * bip[c]; im[c] = zr * bip[c] + zi * brp[c]; }
        bf16* o = W1T + ((size_t)g * 256 + p) * 512 + sg * 16; bf16* o2 = o + (size_t)64 * 512;
        *(v4u*)o = (v4u){pk2(re[0], re[1]), pk2(re[2], re[3]), pk2(re[4], re[5]), pk2(re[6], re[7])}; *(v4u*)(o + 8) = (v4u){pk2(re[8], re[9]), pk2(re[10], re[11]), pk2(re[12], re[13]), pk2(re[14], re[15])};
        *(v4u*)o2 = (v4u){pk2(im[0], im[1]), pk2(im[2], im[3]), pk2(im[4], im[5]), pk2(im[6], im[7])}; *(v4u*)(o2 + 8) = (v4u){pk2(im[8], im[9]), pk2(im[10], im[11]), pk2(im[12], im[13]), pk2(im[14], im[15])}; }
    for (int it = it0; it < 32 * 128 * 64; it += NT) { const int g = it >> 13, r = it & 8191; *(v4u*)(W1T + ((size_t)g * 256 + 128) * 512 + (size_t)r * 8) = (v4u){0u, 0u, 0u, 0u}; }
    for (int it = it0; it < 32 * 32 * 64; it += NT) { const int p = it & 63, tau = (it >> 6) & 31, g = it >> 11; const float delta = expf(P.lstep[g]); float pr, pi; cpow(P.lre[g * 64 + p], P.lim[g * 64 + p], delta, (float)(tau + 1), pr, pi);
#pragma unroll 4
        for (int cp = 0; cp < 16; ++cp) { const float c_r = P.cre[(g * 16 + cp) * 64 + p], c_i = P.cim[(g * 16 + cp) * 64 + p]; bf16* o = WYT + ((size_t)g * 512 + tau * 16 + cp) * 640 + 512 + p;
            o[0] = (bf16)f2bf(c_r * pr - c_i * pi); o[64] = (bf16)f2bf(-(c_r * pi + c_i * pr)); } }
}
__device__ __forceinline__ void s5_fill_T(const Frame& F, const float* KMAT, bf16* WYT) {
    for (int it = F.bx * NTHR + F.tid; it < 32 * 512 * 64; it += F.G * NTHR) { const int k0 = (it & 63) * 8, n = (it >> 6) & 511, g = it >> 15; const int sg = k0 >> 4, c0 = k0 & 15, tau = n >> 4, cp = n & 15;
        v4u w = {0u, 0u, 0u, 0u};
        if (tau >= sg) { const float* k = KMAT + ((size_t)((g * 32 + (tau - sg)) * 16 + cp)) * 16 + c0; const f32x4 a = *(const f32x4*)k, b = *(const f32x4*)(k + 4); w = (v4u){pk2(a[0], a[1]), pk2(a[2], a[3]), pk2(b[0], b[1]), pk2(b[2], b[3])}; }
        *(v4u*)(WYT + ((size_t)g * 512 + n) * 640 + k0) = w; }
}
__device__ __forceinline__ void s5_scan_phase(const Frame& F, const S5P& P, const float* __restrict__ SLOC, bf16* __restrict__ UX) {
    for (int it = F.gw; it < 256; it += F.NGW) { const int g = it & 31, b = it >> 5, p = F.lane; const float delta = expf(P.lstep[g]); float ar, ai_; cpow(P.lre[g * 64 + p], P.lim[g * 64 + p], delta, 32.f, ar, ai_);
        float xr = 0.f, xi = 0.f; const float* s = SLOC + ((size_t)g * 1024 + b * 128) * 128 + p; bf16* o = UX + ((size_t)g * 1024 + b * 128) * 640 + 512 + p;
        for (int c0 = 0; c0 < 128; c0 += 32) { float sr[32], si[32];
#pragma unroll
            for (int c = 0; c < 32; ++c) { sr[c] = s[(size_t)(c0 + c) * 128]; si[c] = s[(size_t)(c0 + c) * 128 + 64]; }
#pragma unroll
            for (int c = 0; c < 32; ++c) { o[(size_t)(c0 + c) * 640] = (bf16)f2bf(xr); o[(size_t)(c0 + c) * 640 + 64] = (bf16)f2bf(xi);
                const float nr = ar * xr - ai_ * xi + sr[c], ni = ar * xi + ai_ * xr + si[c]; xr = nr; xi = ni; } } }
}

struct Args { const float* in[NIN]; float* out; unsigned char* ws; int ph_lo, ph_hi; };
__device__ __forceinline__ int opq(int k) { asm volatile("" : "+s"(k)); return k; }
__device__ __forceinline__ void prologue_build(const Frame& F, const Args& a) {
    unsigned char* ws = a.ws;
    LAS float* scr = (LAS float*)(F.lds + F.wave * 16384);
    S5P sp{a.in[7], a.in[8], a.in[9], a.in[10], a.in[11], a.in[12], a.in[13], a.in[14]};
    s5_build(F, sp, (bf16*)(ws + WS_W1T), (bf16*)(ws + WS_WYT), (float*)(ws + WS_KMAT));
    if (PROBE_ID == 43) s5_build(F, sp, (bf16*)(ws + WS_W1T), (bf16*)(ws + WS_WYT), (float*)(ws + WS_KMAT));
#define TR_MAT(Wp, Kd, Nd, WTp, mode, lim, HG, gainp) { constexpr int nblk_ = (Nd) / 32, kblk_ = (Kd) / 64, kgr_ = (kblk_ + 7) / 8; if (r < nblk_ * kgr_) { const int nb_ = r % nblk_, kb_ = (r / nblk_) * 8 + F.wave; \
        if (kb_ < kblk_) transpose_item<HG>(Wp, Kd, Nd, WTp, mode, lim, scr, kb_ * nblk_ + nb_, F.lane, gainp); continue; } r -= nblk_ * kgr_; }
    constexpr int WI_A = 80 * 2 + 32 * 2 + 16 * 1 + 96 * 2 + 32 * 2, WI_L = 88 * 2 + 88 * 2 + 32 * 6 + 32 * 1 + 32 * 2;
    for (int rep_ = 0; rep_ < (PROBE_ID == 44 ? 2 : 1); ++rep_)
    for (int wi = F.bx; wi < WI_A + 2 * WI_L; wi += F.G) { int r = wi;
        TR_MAT(a.in[5], 1024, 2560, (bf16*)(ws + WS_WIN), 1, 1024, true, a.in[2])
        TR_MAT(a.in[6], 1024, 1024, (bf16*)(ws + WS_WOUT), 0, 0, false, nullptr)
        TR_MAT(a.in[15], 512, 512, (bf16*)(ws + WS_WGLU), 0, 0, false, nullptr)
        TR_MAT(a.in[16], 1024, 3072, (bf16*)(ws + WS_WQKV), 1, 2048, true, a.in[2] + 1024)
        TR_MAT(a.in[17], 1024, 1024, (bf16*)(ws + WS_WO), 0, 0, false, nullptr)
        const int L = r / WI_L; r -= L * WI_L;
        TR_MAT(a.in[23] + (size_t)L * 1024 * FF, 1024, FF, (bf16*)(ws + WS_WGU + L * SZ_WGU), 2, 0, true, a.in[3] + L * 1024)
        TR_MAT(a.in[24] + (size_t)L * 1024 * FF, 1024, FF, (bf16*)(ws + WS_WGU + L * SZ_WGU), 3, 0, true, a.in[3] + L * 1024)
        TR_MAT(a.in[25] + (size_t)L * FF * 1024, FF, 1024, (bf16*)(ws + WS_WDN + L * SZ_WDN), 0, 0, false, nullptr)
        TR_MAT(a.in[26] + (size_t)L * 256 * 1024, 256, 1024, (bf16*)(ws + WS_WPP + L * SZ_WPP), 0, 0, false, nullptr)
        TR_MAT(a.in[27] + (size_t)L * 1024 * 1024, 1024, 1024, (bf16*)(ws + WS_WPG + L * SZ_WPG), 0, 0, true, a.in[4] + L * 1024)
    }
#undef TR_MAT
    if (F.bx == 0 && F.tid < 128) ((float*)(ws + WS_GN))[F.tid] = a.in[22][F.tid] * (1.f - (0.8f - 0.6f * 0.7408182206817179f));
    { float* cs = (float*)(ws + WS_CS);
      for (int it = F.bx * NTHR + F.tid; it < SEQL * 32; it += F.G * NTHR) { const int i = it & 31, pos = it >> 5; const float inv = exp2f(-(float)i * (13.287712379549449f / 32.f)); float s, c; sincos_rad((float)pos * inv, s, c);
          cs[pos * 64 + i] = c; cs[pos * 64 + 32 + i] = s; } }
}
__device__ __forceinline__ void prologue_stream(const Frame& F, const Args& a) {
    unsigned char* ws = a.ws;
    { const float* p = a.in[1]; bf16* pb = (bf16*)(ws + WS_PB);
      const size_t T_ = (size_t)F.G * NTHR;
      for (size_t it = (size_t)F.bx * NTHR + F.tid; it < (size_t)2 * M * 256 / 8; it += 4 * T_) { f32x4 x0[4], x1[4];
#pragma unroll
          for (int q = 0; q < 4; ++q) { const size_t i2 = it + q * T_; if (i2 < (size_t)2 * M * 256 / 8) { x0[q] = __builtin_nontemporal_load((const f32x4*)(p + i2 * 8)); x1[q] = __builtin_nontemporal_load((const f32x4*)(p + i2 * 8 + 4)); } }
#pragma unroll
          for (int q = 0; q < 4; ++q) { const size_t i2 = it + q * T_; if (i2 < (size_t)2 * M * 256 / 8) *(v4u*)(pb + i2 * 8) = (v4u){pk2(x0[q][0], x0[q][1]), pk2(x0[q][2], x0[q][3]), pk2(x1[q][0], x1[q][1]), pk2(x1[q][2], x1[q][3])}; } } }
    { const float* x = a.in[0]; bf16* hb = (bf16*)(ws + WS_HN); float* ssq = (float*)(ws + WS_SSP);
      for (int m0 = F.gw; m0 < M; m0 += 4 * F.NGW) { f32x4 v[4][4];
#pragma unroll
          for (int q = 0; q < 4; ++q) { const int m = m0 + q * F.NGW; if (m < M) { const f32x4* xr = (const f32x4*)(x + (size_t)m * DM_) + F.lane;
#pragma unroll
              for (int j = 0; j < 4; ++j) v[q][j] = __builtin_nontemporal_load(xr + 64 * j); } }
#pragma unroll
          for (int q = 0; q < 4; ++q) { const int m = m0 + q * F.NGW; if (m < M) { v2u* o8 = (v2u*)(hb + (size_t)m * DM_) + F.lane; float s = 0.f;
#pragma unroll
              for (int j = 0; j < 4; ++j) { const f32x4 t = v[q][j]; s += (t.x * t.x + t.y * t.y) + (t.z * t.z + t.w * t.w); v2u w; w.x = pk2(t.x, t.y); w.y = pk2(t.z, t.w); o8[64 * j] = w; }
              s = wave_sum(s); if (F.lane < 16) ssq[(size_t)m * 16 + F.lane] = F.lane == 0 ? s : 0.f; } } } }
}

constexpr int NPHASE = 17;
__global__ void __launch_bounds__(NTHR, 2) hybrid_fwd(Args args) {
    extern __shared__ __attribute__((aligned(16))) unsigned char lds[];
    cg::grid_group grid = cg::this_grid();
    unsigned char* const ws = args.ws; float* const H = args.out;
    const int lo = args.ph_lo, hi = args.ph_hi;
#ifndef PH_MASK
#define PH_MASK 0xffffffu
#endif
#define IN(k) (lo <= (k) && (k) < hi && ((PH_MASK >> (k)) & 1u))
#define SEAM(k) do { if (IN((k) + 1)) grid.sync(); } while (0)
#define MKF() Frame F; { int t_ = threadIdx.x; asm volatile("" : "+v"(t_)); F.lds = (LAS unsigned char*)lds; F.tid = t_; F.lane = t_ & 63; F.wave = __builtin_amdgcn_readfirstlane(t_ >> 6); \
        F.G = gridDim.x; F.bx = blockIdx.x; F.gw = F.wave * F.G + F.bx; F.NGW = F.G * NWAVES; }
#define INP(k) (args.in[opq(k)])
#define WSB(off) ((bf16*)(ws + (off)))
#define GEMM_STD(Aptr, Bptr, ldk, Ncols, EpiT, Eobj) do { pg8::Gemm g_{(const bf16*)(Aptr), (const bf16*)(Bptr), (ldk), (ldk), (ldk), 0, 0}; pg8::StaticOrder S_; S_.init(M, (Ncols), (int)gridDim.x, (int)blockIdx.x); \
        pg8::gemm_phase<EpiT, pg8::StaticOrder, true, true>((LAS unsigned char*)lds, g_, S_, Eobj); } while (0)

#ifndef PROBE_ID
#define PROBE_ID 0
#endif
#define XCDLOCAL() ((gridDim.x % 8 == 0) ? (int)((blockIdx.x % 8) * (gridDim.x / 8) + blockIdx.x / 8) : (int)blockIdx.x)
#define BODY0 { MKF(); prologue_build(F, args); if (PROBE_ID == 41) prologue_build(F, args); prologue_stream(F, args); if (PROBE_ID == 42) prologue_stream(F, args); }
#define BODY2 { { pg8::Gemm g_{WSB(WS_UX), WSB(WS_W1T), 640, 512, 512, (size_t)1024 * 640, (size_t)256 * 512}; GroupOrder S_{4, 1, 32, (int)gridDim.x, XCDLOCAL()}; EpiSloc E{(float*)(ws + WS_SLOC)}; \
                   pg8::gemm_phase<EpiSloc, GroupOrder, true, true>((LAS unsigned char*)lds, g_, S_, E); } \
                 MKF(); ret_kv_phase(F, WSB(WS_PROJ), (float*)(ws + WS_KV)); }
#define BODY3 { MKF(); S5P sp{INP(7), INP(8), INP(9), INP(10), INP(11), INP(12), INP(13), INP(14)}; \
                 s5_scan_phase(F, sp, (const float*)(ws + WS_SLOC), WSB(WS_UX)); ret_scan_phase(F, (const float*)(ws + WS_KV), WSB(WS_RT)); s5_fill_T(F, (const float*)(ws + WS_KMAT), WSB(WS_WYT)); }
#define BODY4A { pg8::Gemm g_{WSB(WS_UX), WSB(WS_WYT), 640, 640, 640, (size_t)1024 * 640, (size_t)512 * 640}; GroupOrder S_{4, 2, 32, (int)gridDim.x, XCDLOCAL()}; EpiS5Y E{WSB(WS_UX), WSB(WS_Y), INP(13)}; \
                   pg8::gemm_phase<EpiS5Y, GroupOrder, true, true>((LAS unsigned char*)lds, g_, S_, E); }
#define BODY4B { MKF(); ret_out_phase(F, WSB(WS_PROJ), WSB(WS_RT), WSB(WS_MIX)); }
#define BODY4 { BODY4A; if (PROBE_ID == 1041) BODY4A; BODY4B; if (PROBE_ID == 1042) BODY4B; }
#define BODY14 { const int G_ = gridDim.x, bx_ = blockIdx.x; const int vcu = (G_ % 8 == 0) ? (bx_ % 8) * (G_ / 8) + bx_ / 8 : bx_; float lam_; \
                  { int t_ = threadIdx.x; asm volatile("" : "+v"(t_)); const int l_ = t_ & 63; lam_ = expf(wave_sum(INP(18)[l_] * INP(19)[l_])) - expf(wave_sum(INP(20)[l_] * INP(21)[l_])) + (0.8f - 0.6f * 0.7408182206817179f); } \
                  attn_body::attn_phase<8>((char*)lds, (const attn_body::bf16*)(ws + WS_PROJ), (attn_body::bf16*)(ws + WS_HN), (attn_body::bf16*)(ws + WS_PP), (long)M * 1024, lam_, (const float*)(ws + WS_GN), G_, vcu); }
    if (threadIdx.x < 64) ((LAS unsigned*)lds)[(131072 >> 2) + threadIdx.x] = 0u;
    __syncthreads();
    XcdBarrier bar = xcd_barrier_post((unsigned*)(ws + WS_BAR), (volatile LAS unsigned*)((LAS unsigned char*)lds + MISC_OFF));
#undef SEAM
#define SEAM(k) do { if (hi > (k) + 1) { if (lo > hi) grid.sync(); xcd_barrier(bar); } } while (0)
#define SSQ(i) ((float*)(ws + WS_SSP) + (size_t)((i) & 1) * M * 16)
    if (IN(0)) { BODY0; if (PROBE_ID == 4) { BODY0; } SEAM(0); if (PROBE_ID == 6) { for (int r_ = 0; r_ < 20; ++r_) xcd_barrier(bar); } }
#define BODY1 { EpiProj<0> E{WSB(WS_PROJ), (const float*)(ws + WS_CS), WSB(WS_UX), SSQ(0)}; GEMM_STD(WSB(WS_HN), WSB(WS_WIN), 1024, 2560, EpiProj<0>, E); }
    if (IN(1)) { BODY1; if (PROBE_ID == 101) BODY1; SEAM(1); }
    if (IN(2)) { BODY2; if (PROBE_ID == 102) BODY2; SEAM(2); }
    if (IN(3)) { BODY3; if (PROBE_ID == 103) BODY3; SEAM(3); }
    if (IN(4)) { BODY4; if (PROBE_ID == 104) BODY4; SEAM(4); }
    if (IN(5)) { EpiGlu E{WSB(WS_Y), WSB(WS_MIX)}; GEMM_STD(WSB(WS_Y), WSB(WS_WGLU), 512, 512, EpiGlu, E); SEAM(5); }
#define BODY6 { EpiRes<true> E{INP(0), WSB(WS_HN), SSQ(1)}; GEMM_STD(WSB(WS_MIX), WSB(WS_WOUT), 1024, 1024, EpiRes<true>, E); }
    if (IN(6)) { BODY6; if (PROBE_ID == 106) BODY6; SEAM(6); }
#define FFN_PLE(L, pb, si, R, Rn)   \
    if (IN((pb) + 0)) { EpiSwiglu E{WSB(WS_ACT), SSQ(si)}; GEMM_STD(WSB(R), WSB(WS_WGU + (L) * SZ_WGU), 1024, 5632, EpiSwiglu, E); if (PROBE_ID == 5 && (L) == 0) { GEMM_STD(WSB(R), WSB(WS_WGU + (L) * SZ_WGU), 1024, 5632, EpiSwiglu, E); } SEAM((pb) + 0); } \
    if (IN((pb) + 1)) { { EpiRes<false> E{WSB(R), WSB(R), SSQ((si) + 1)}; GEMM_STD(WSB(WS_ACT), WSB(WS_WDN + (L) * SZ_WDN), FF, 1024, EpiRes<false>, E); } \
                        EpiPlain E2{WSB(WS_PP)}; GEMM_STD(WSB(WS_PB) + (size_t)(L) * M * 256, WSB(WS_WPP + (L) * SZ_WPP), opq(256), 1024, EpiPlain, E2); SEAM((pb) + 1); } \
    if (IN((pb) + 2)) { EpiPle E{WSB(WS_PP), WSB(R), SSQ((si) + 1), WSB(Rn), SSQ((si) + 2)}; GEMM_STD(WSB(R), WSB(WS_WPG + (L) * SZ_WPG), 1024, 1024, EpiPle, E); if (PROBE_ID == 109 && (L) == 0) { GEMM_STD(WSB(R), WSB(WS_WPG + (L) * SZ_WPG), 1024, 1024, EpiPle, E); } SEAM((pb) + 2); }
    FFN_PLE(0, 7, 1, WS_HN, WS_MIX)
    if (IN(10)) { EpiProj<1> E{WSB(WS_PROJ), (const float*)(ws + WS_CS), nullptr, SSQ(3)}; GEMM_STD(WSB(WS_MIX), WSB(WS_WQKV), 1024, 3072, EpiProj<1>, E); SEAM(10); }
    if (IN(11)) { BODY14; if (PROBE_ID == 2) { BODY14; } if (hi > 13) xcd_barrier(bar); }
    if (IN(13)) { EpiRes<false> E{WSB(WS_MIX), WSB(WS_MIX), SSQ(4)}; GEMM_STD(WSB(WS_PP), WSB(WS_WO), 1024, 1024, EpiRes<false>, E); SEAM(13); }
    FFN_PLE(1, 14, 4, WS_MIX, WS_HN)
    if (IN(17)) { MKF(); final_norm_phase(F, WSB(WS_HN), SSQ(6), INP(28), H); }
#undef IN
#undef SEAM
#undef GEMM_STD
}

#ifndef MK_PER_PHASE
#define MK_PER_PHASE 0
#endif
extern "C" void kernel_launch(void* const* d_in, const int* in_sizes, int n_in, void* d_out, int out_size, void* d_ws, size_t ws_size, hipStream_t stream) {
    static int grid = 0;
    if (grid == 0) {
        if (n_in != NIN || out_size != M * DM_ || ws_size < WS_END) { fprintf(stderr, "kernel_launch: unexpected problem: n_in %d out %d ws %zu\n", n_in, out_size, ws_size); grid = -1; return; }
        int dev = 0, cus = 0, per_cu = 0;
        hipGetDevice(&dev); hipDeviceGetAttribute(&cus, hipDeviceAttributeMultiprocessorCount, dev);
        if (hipFuncSetAttribute((const void*)hybrid_fwd, hipFuncAttributeMaxDynamicSharedMemorySize, LDS_BYTES) != hipSuccess) { fprintf(stderr, "kernel_launch: hipFuncSetAttribute failed\n"); grid = -1; return; }
        if (hipOccupancyMaxActiveBlocksPerMultiprocessor(&per_cu, (const void*)hybrid_fwd, NTHR, LDS_BYTES) != hipSuccess || per_cu < 1) { fprintf(stderr, "kernel_launch: occupancy query says %d\n", per_cu); per_cu = 1; }
        (void)hipGetLastError();
        grid = cus * 1;
        fprintf(stderr, "kernel_launch: grid %d (cus %d, per_cu %d)\n", grid, cus, per_cu);
    }
    if (grid < 0) return;
    if (hipMemsetAsync((char*)d_ws + WS_CTL, 0, CTL_ZERO_BYTES, stream) != hipSuccess) { fprintf(stderr, "kernel_launch: hipMemsetAsync failed\n"); return; }
    Args a{};
    for (int i = 0; i < NIN; ++i) a.in[i] = (const float*)d_in[i];
    a.out = (float*)d_out; a.ws = (unsigned char*)d_ws;
#if MK_PER_PHASE
    for (int ph = 0; ph <= NPHASE; ++ph) { a.ph_lo = ph; a.ph_hi = ph + 1; hipLaunchKernelGGL(hybrid_fwd, dim3(grid), dim3(NTHR), LDS_BYTES, stream, a); }
#else
    a.ph_lo = 0; a.ph_hi = NPHASE + 1;
    void* kargs[] = {&a};
    hipError_t e = hipLaunchCooperativeKernel((const void*)hybrid_fwd, dim3(grid), dim3(NTHR), kargs, LDS_BYTES, stream);
    if (e != hipSuccess) fprintf(stderr, "kernel_launch: cooperative launch failed: %s (grid %d)\n", hipGetErrorString(e), grid);
#endif
}
```

```cpp
#include <hip/hip_runtime.h>
#include <cstdio>
#include <cstdint>
#include <hip/hip_cooperative_groups.h>
namespace pg8 {
#define PG8_LAS __attribute__((address_space(3)))
typedef unsigned short bf16_t;
typedef short bf16x8 __attribute__((ext_vector_type(8)));
typedef float f32x4 __attribute__((ext_vector_type(4)));
typedef unsigned u32x4 __attribute__((ext_vector_type(4)));
constexpr int BM = 256, BK = 64, HALF = 128, HTB = HALF * BK * 2  , STAGE_BYTES = 8 * HTB, NXCD = 8, WGM = 4;

__host__ __device__ __forceinline__ int lds_byte(int r, int c) { const int st = (r >> 4) * 2 + (c >> 5), rr = r & 15, cc = c & 31, ob = rr * 64 + cc * 2; return st * 1024 + (ob ^ (((ob >> 9) & 1) << 5)); }
__host__ __device__ __forceinline__ void stage_rc(int b, int& R, int& C) { const int st = b / 1024, sb = b % 1024, swz = sb ^ (((sb >> 9) & 1) << 5); R = (st >> 1) * 16 + swz / 64; C = (st & 1) * 32 + (swz % 64) / 2; }
__host__ __device__ __forceinline__ int perm32(int rho) { const int n = rho >> 4, i = rho & 15; return 8 * (i >> 2) + 4 * n + (i & 3); }

struct Unit { int pm, pn, g; };
struct Gemm { const bf16_t* A; const bf16_t* Bt; int lda, ldb, K; size_t gsA, gsB; };

struct StaticOrder {
    int nM, nN, nwg, G, c;
    __host__ __device__ void init(int M, int N, int G_, int c_) { nM = M / BM; nN = N / BM; nwg = nM * nN; G = G_; c = c_; }
    __host__ __device__ bool next(int i, Unit& u) const {
        const long L = (long)i * G + c; if (L >= nwg) return false;
        int wgid = (int)L; { const int q = nwg / NXCD, r = nwg % NXCD, xcd = wgid % NXCD, off = wgid / NXCD; wgid = (xcd < r ? xcd * (q + 1) : r * (q + 1) + (xcd - r) * q) + off; }
        const int nig = WGM * nN, gid = wgid / nig, fm = gid * WGM, gsz = (nM - fm) < WGM ? (nM - fm) : WGM;
        u.pm = fm + ((wgid % nig) % gsz); u.pn = (wgid % nig) / gsz; u.g = 0; return true;
    }
    __device__ __forceinline__ void a_ready(const Unit&) const {}
    __device__ __forceinline__ void done(const Unit&) const {}
};

__device__ __forceinline__ unsigned cvt_pk_bf16(float lo, float hi) { unsigned r; asm volatile("v_cvt_pk_bf16_f32 %0, %1, %2" : "=v"(r) : "v"(lo), "v"(hi)); return r; }
typedef float f32x2 __attribute__((ext_vector_type(2)));
__device__ __forceinline__ f32x2 gelu_pk(f32x2 v) {
    const f32x2 av = __builtin_elementwise_abs(v), d = av * 0.2316418882f + 1.0f;
    f32x2 t; t.x = __builtin_amdgcn_rcpf(d.x); t.y = __builtin_amdgcn_rcpf(d.y);
    f32x2 q = t * 0.5307027145f + (-0.7265760135f); q = q * t + 0.7107068705f; q = q * t + (-0.142248368f); q = q * t + 0.127414796f; q = q * t;
    const f32x2 s = (v * v) * (-0.72134752044f);
    f32x2 e; e.x = __builtin_amdgcn_exp2f(s.x); e.y = __builtin_amdgcn_exp2f(s.y);
    const f32x2 m = v * (q * e), r = v - m;
    f32x2 o; o.x = v.x < 0.f ? m.x : r.x; o.y = v.y < 0.f ? m.y : r.y; return o;
}

template <int ACT  > struct EpiBf16 {
    static constexpr bool PERM = true, AFTER_DRAIN = false; static_assert(ACT == 0 || ACT == 1, "EpiBf16: ACT is 0 (none) or 1 (gelu_pk)");
    bf16_t* O; int ldc; const float* bias; int split_cols; size_t split_stride; float scale0;
    __device__ __forceinline__ void operator()(const f32x4 (&acc)[2][2][4][2], const Unit& u, int wr, int wc, int fr, int fq) const {
        const int row0 = u.pm * BM + wr * 64 + fr; int colt = u.pn * BM; bf16_t* base = O;
        float sc = 1.f; if (split_cols) { const int t = colt / split_cols; base += (size_t)t * split_stride; colt -= t * split_cols; if (t == 0) sc = scale0; }
        const int col0 = colt + wc * 32 + 8 * fq, bcol0 = u.pn * BM + wc * 32 + 8 * fq;
        f32x4 bv[2][2];
#pragma unroll
        for (int bj = 0; bj < 2; ++bj)
#pragma unroll
            for (int n = 0; n < 2; ++n) bv[bj][n] = bias ? *(const f32x4*)(bias + bcol0 + bj * HALF + 4 * n) : (f32x4){0.f, 0.f, 0.f, 0.f};
#pragma unroll
        for (int ai = 0; ai < 2; ++ai)
#pragma unroll
            for (int m = 0; m < 4; ++m) { bf16_t* rowp = base + (size_t)(row0 + ai * HALF + m * 16) * ldc + col0;
#pragma unroll
                for (int bj = 0; bj < 2; ++bj) { f32x4 v0 = acc[ai][bj][m][0] + bv[bj][0], v1 = acc[ai][bj][m][1] + bv[bj][1];
                    if (ACT == 1) { f32x2 a = gelu_pk((f32x2){v0[0], v0[1]}), b = gelu_pk((f32x2){v0[2], v0[3]}), c = gelu_pk((f32x2){v1[0], v1[1]}), d = gelu_pk((f32x2){v1[2], v1[3]});
                        v0 = (f32x4){a.x, a.y, b.x, b.y}; v1 = (f32x4){c.x, c.y, d.x, d.y}; }
                    v0 = v0 * sc; v1 = v1 * sc; u32x4 w; w.x = cvt_pk_bf16(v0[0], v0[1]); w.y = cvt_pk_bf16(v0[2], v0[3]); w.z = cvt_pk_bf16(v1[0], v1[1]); w.w = cvt_pk_bf16(v1[2], v1[3]);
                    *(u32x4*)(rowp + bj * HALF) = w; } }
    }
};
template <class Epi, class Sched, bool ALIGN_EPI = false, bool SP2 = false>
__device__ __forceinline__ void gemm_phase(PG8_LAS unsigned char* lds, const Gemm g, const Sched& S, const Epi& E) {
    int tid_ = threadIdx.x; asm volatile("" : "+v"(tid_));
    const int tid = tid_, wid = __builtin_amdgcn_readfirstlane(tid >> 6), lane = tid & 63, wr = wid >> 2, wc = wid & 3, fr = lane & 15, fq = lane >> 4;
    const int K = g.K, nt = K / BK;
    unsigned voffA[2], voffB[2];
#pragma unroll
    for (int i = 0; i < 2; ++i) { int R, C; stage_rc(tid * 16 + i * 8192, R, C); const int Rb = Epi::PERM ? ((R & ~31) + perm32(R & 31)) : R;
        voffA[i] = (unsigned)(R * g.lda + C) * 2u; voffB[i] = (unsigned)(Rb * g.ldb + C) * 2u; }
    const size_t kstep = (size_t)(BK * 2);
    const size_t hstepA = (size_t)HALF * g.lda * 2, hstepB = (size_t)HALF * g.ldb * 2;
    const size_t tstepA = 2 * hstepA, tstepB = 2 * hstepB;
    const unsigned ldsw = (unsigned)wid * 1024u;
    const int aoff = lds_byte(wr * 64 + fr, fq * 8), boff = lds_byte(wc * 32 + fr, fq * 8);
#define PG8_SA(b, h) (((b) * 2 + (h)) * HTB)
#define PG8_SB(b, h) ((4 + (b) * 2 + (h)) * HTB)
#define PG8_STAGE(bufoff, gbase, voff) do { _Pragma("unroll") for (int _i = 0; _i < 2; ++_i) \
        __builtin_amdgcn_global_load_lds((const unsigned*)((const char*)(gbase) + (voff)[_i]), (PG8_LAS unsigned*)(lds + (bufoff) + ldsw + _i * 8192), 16, 0, 0); } while (0)
#define PG8_LDA(dst, b, h) do { _Pragma("unroll") for (int m = 0; m < 4; ++m) _Pragma("unroll") for (int k = 0; k < 2; ++k) dst[m][k] = *(const PG8_LAS bf16x8*)(lds + PG8_SA(b, h) + aoff + m * 2048 + k * 1024); } while (0)
#define PG8_LDB(dst, b, h) do { _Pragma("unroll") for (int n = 0; n < 2; ++n) _Pragma("unroll") for (int k = 0; k < 2; ++k) dst[n][k] = *(const PG8_LAS bf16x8*)(lds + PG8_SB(b, h) + boff + n * 2048 + k * 1024); } while (0)
#define PG8_MMA(ai, bj, At, Bt) do { __builtin_amdgcn_s_setprio(1); _Pragma("unroll") for (int m = 0; m < 4; ++m) _Pragma("unroll") for (int n = 0; n < 2; ++n) _Pragma("unroll") for (int k = 0; k < 2; ++k) \
        acc[ai][bj][m][n] = __builtin_amdgcn_mfma_f32_16x16x32_bf16(Bt[n][k], At[m][k], acc[ai][bj][m][n], 0, 0, 0); __builtin_amdgcn_s_setprio(0); } while (0)
#define PG8_WAIT_V(n) asm volatile("s_waitcnt vmcnt(" #n ")" ::: "memory")
#define PG8_WAIT_L(n) asm volatile("s_waitcnt lgkmcnt(" #n ")" ::: "memory")
#define PG8_BAR __builtin_amdgcn_s_barrier()
#define PG8_SCHED __builtin_amdgcn_sched_barrier(0)
    Unit cur, nxt; int ui = 0;
    if (!S.next(0, cur)) return;
    f32x4 acc[2][2][4][2];
#pragma unroll
    for (int a = 0; a < 2; ++a)
#pragma unroll
        for (int b = 0; b < 2; ++b)
#pragma unroll
            for (int m = 0; m < 4; ++m)
#pragma unroll
                for (int n = 0; n < 2; ++n) acc[a][b][m][n] = (f32x4){0.f, 0.f, 0.f, 0.f};
    bf16x8 At[4][2], B0[2][2], B1[2][2];
    const char* cA = (const char*)g.A + (size_t)cur.g * g.gsA * 2 + (size_t)cur.pm * tstepA; const char* cB = (const char*)g.Bt + (size_t)cur.g * g.gsB * 2 + (size_t)cur.pn * tstepB;
    S.a_ready(cur);
    if constexpr (SP2) {
        PG8_STAGE(PG8_SB(0, 0), cB, voffB); PG8_STAGE(PG8_SB(0, 1), cB + hstepB, voffB); PG8_STAGE(PG8_SA(0, 0), cA, voffA); PG8_STAGE(PG8_SA(0, 1), cA + hstepA, voffA);
        if (wr == 1) PG8_BAR;
        PG8_WAIT_V(2); PG8_BAR;
        PG8_STAGE(PG8_SB(1, 0), cB + kstep, voffB); PG8_STAGE(PG8_SA(1, 0), cA + kstep, voffA); PG8_STAGE(PG8_SB(1, 1), cB + hstepB + kstep, voffB);
        PG8_WAIT_V(6); PG8_BAR;
    } else {
        PG8_STAGE(PG8_SB(0, 0), cB, voffB); PG8_STAGE(PG8_SA(0, 0), cA, voffA); PG8_STAGE(PG8_SB(0, 1), cB + hstepB, voffB); PG8_STAGE(PG8_SA(0, 1), cA + hstepA, voffA);
        if (wr == 1) PG8_BAR;
        PG8_WAIT_V(4); PG8_BAR;
        PG8_STAGE(PG8_SB(1, 0), cB + kstep, voffB); PG8_STAGE(PG8_SA(1, 0), cA + kstep, voffA); PG8_STAGE(PG8_SB(1, 1), cB + hstepB + kstep, voffB);
        PG8_WAIT_V(6); PG8_BAR;
    }
    for (;;) {
        const bool has_next = S.next(ui + 1, nxt);
        const char* nA = has_next ? (const char*)g.A + (size_t)nxt.g * g.gsA * 2 + (size_t)nxt.pm * tstepA : cA; const char* nB = has_next ? (const char*)g.Bt + (size_t)nxt.g * g.gsB * 2 + (size_t)nxt.pn * tstepB : cB;
        for (int t = 0; t < nt; t += 2) {
            const bool last = (t == nt - 2);
            const char* a1 = cA + (size_t)(t + 1) * kstep;
            const char* a2 = last ? nA : cA + (size_t)(t + 2) * kstep; const char* b2 = last ? nB : cB + (size_t)(t + 2) * kstep;
            const char* a3 = a2 + kstep; const char* b3 = b2 + kstep;
            if (last && has_next) S.a_ready(nxt);
            if constexpr (SP2) {
            PG8_LDB(B0, 0, 0); PG8_LDB(B1, 0, 1); PG8_SCHED; PG8_LDA(At, 0, 0); PG8_STAGE(PG8_SA(1, 1), a1 + hstepA, voffA);
            PG8_WAIT_V(8); PG8_WAIT_L(0); PG8_BAR; PG8_MMA(0, 0, At, B0); PG8_MMA(0, 1, At, B1); PG8_BAR; PG8_SCHED;
            PG8_LDA(At, 0, 1); PG8_STAGE(PG8_SB(0, 0), b2, voffB); PG8_STAGE(PG8_SB(0, 1), b2 + hstepB, voffB); PG8_STAGE(PG8_SA(0, 0), a2, voffA);
            PG8_WAIT_V(8); PG8_WAIT_L(0); PG8_BAR; PG8_MMA(1, 0, At, B0); PG8_MMA(1, 1, At, B1); PG8_BAR; PG8_SCHED;
            PG8_LDB(B0, 1, 0); PG8_LDB(B1, 1, 1); PG8_SCHED; PG8_LDA(At, 1, 0); PG8_STAGE(PG8_SA(0, 1), a2 + hstepA, voffA);
            PG8_WAIT_V(8); PG8_WAIT_L(0); PG8_BAR; PG8_MMA(0, 0, At, B0); PG8_MMA(0, 1, At, B1); PG8_BAR; PG8_SCHED;
            PG8_LDA(At, 1, 1); PG8_STAGE(PG8_SB(1, 0), b3, voffB); PG8_STAGE(PG8_SB(1, 1), b3 + hstepB, voffB); PG8_STAGE(PG8_SA(1, 0), a3, voffA);
            PG8_WAIT_V(8); PG8_WAIT_L(0); PG8_BAR; PG8_MMA(1, 0, At, B0); PG8_MMA(1, 1, At, B1); PG8_BAR; PG8_SCHED;
            } else {
            PG8_LDB(B0, 0, 0); PG8_SCHED; PG8_LDA(At, 0, 0); PG8_STAGE(PG8_SA(1, 1), a1 + hstepA, voffA);
            PG8_WAIT_L(8); PG8_BAR; PG8_WAIT_L(0); PG8_MMA(0, 0, At, B0); PG8_BAR; PG8_SCHED;
            PG8_LDB(B1, 0, 1); PG8_STAGE(PG8_SB(0, 0), b2, voffB);
            PG8_BAR; PG8_WAIT_L(0); PG8_MMA(0, 1, At, B1); PG8_BAR;
            PG8_LDA(At, 0, 1); PG8_STAGE(PG8_SA(0, 0), a2, voffA);
            PG8_BAR; PG8_WAIT_L(0); PG8_MMA(1, 0, At, B0); PG8_BAR; PG8_SCHED;
            PG8_STAGE(PG8_SB(0, 1), b2 + hstepB, voffB);
            PG8_WAIT_V(6); PG8_BAR; PG8_MMA(1, 1, At, B1); PG8_BAR;
            PG8_LDB(B0, 1, 0); PG8_SCHED; PG8_LDA(At, 1, 0); PG8_STAGE(PG8_SA(0, 1), a2 + hstepA, voffA);
            PG8_WAIT_L(8); PG8_BAR; PG8_WAIT_L(0); PG8_MMA(0, 0, At, B0); PG8_BAR; PG8_SCHED;
            PG8_LDB(B1, 1, 1); PG8_STAGE(PG8_SB(1, 0), b3, voffB);
            PG8_BAR; PG8_WAIT_L(0); PG8_MMA(0, 1, At, B1); PG8_BAR;
            PG8_LDA(At, 1, 1); PG8_STAGE(PG8_SA(1, 0), a3, voffA);
            PG8_BAR; PG8_WAIT_L(0); PG8_MMA(1, 0, At, B0); PG8_BAR; PG8_SCHED;
            PG8_STAGE(PG8_SB(1, 1), b3 + hstepB, voffB);
            PG8_WAIT_V(6); PG8_BAR; PG8_MMA(1, 1, At, B1); PG8_BAR;
            }
        }
        if constexpr (ALIGN_EPI) { if (wr == 0) PG8_BAR; }
        if constexpr (!Epi::AFTER_DRAIN) { E(acc, cur, wr, wc, fr, fq); S.done(cur); }
        if (!has_next) break;
#pragma unroll
        for (int a = 0; a < 2; ++a)
#pragma unroll
            for (int b = 0; b < 2; ++b)
#pragma unroll
                for (int m = 0; m < 4; ++m)
#pragma unroll
                    for (int n = 0; n < 2; ++n) acc[a][b][m][n] = (f32x4){0.f, 0.f, 0.f, 0.f};
        cur = nxt; cA = nA; cB = nB; ++ui;
        if constexpr (ALIGN_EPI) { if (wr == 1) PG8_BAR; }
    }
    PG8_WAIT_V(0);
    if constexpr (!ALIGN_EPI) { if (wr == 0) PG8_BAR; }
    PG8_BAR;
    if constexpr (Epi::AFTER_DRAIN) { E.fused(acc, cur, wr, wc, fr, fq, lds, wid, lane); S.done(cur); }
#undef PG8_SA
#undef PG8_SB
#undef PG8_STAGE
#undef PG8_LDA
#undef PG8_LDB
#undef PG8_MMA
#undef PG8_WAIT_V
#undef PG8_WAIT_L
#undef PG8_BAR
#undef PG8_SCHED
}
}

#ifndef PG8_SP2
#define PG8_SP2 true
#endif
#ifndef PG8_ALIGN
#define PG8_ALIGN true
#endif
#include <hip/hip_bf16.h>
#include <cmath>
namespace attn_body {
using bf16=__hip_bfloat16;
using bf16x8=__attribute__((ext_vector_type(8)))short;
using s16x4=__attribute__((ext_vector_type(4)))short;
using f32x16=__attribute__((ext_vector_type(16)))float;
using u32x4=__attribute__((ext_vector_type(4)))unsigned;
constexpr int BATCH=8,SEQ=4096,D=64,DM=1024,DMO=1024;
constexpr int NW=8,QBLK=32,QB=QBLK*NW,KVBLK=64,NQB=SEQ/QB;
constexpr int ATTN_PITCH=DM, ATTN_UNIT_ROWS=QB;
__device__ __forceinline__ int crow(int r,int hi){return (r&3)+8*(r>>2)+4*hi;}
#define SBAR() __builtin_amdgcn_sched_barrier(0)
__device__ __forceinline__ void cmask(f32x16&p0,f32x16&p1,int jb,int qrel,int hi){
  const float NEG=-INFINITY; int kb=64*jb+4*hi;
  #pragma unroll
  for(int r=0;r<16;++r){int kv=kb+(r&3)+8*(r>>2); if(kv>qrel)p0[r]=NEG; if(kv+32>qrel)p1[r]=NEG;}
}

constexpr int NSLOT=3, SLOTB=8192;
constexpr int LDS_K=0, LDS_V=NSLOT*SLOTB, LDS_WS=LDS_V+NSLOT*2*SLOTB, LDS_OST=LDS_WS+NW*64*4, LDS_BYTES=LDS_OST+NW*4096;
constexpr float C2=0.125f*1.4426950408889634f;
__device__ __forceinline__ void glds16(const void*gsrc,unsigned lds_dst){unsigned keep;
  asm volatile("s_mov_b32 %0, m0\n\ts_mov_b32 m0, %2\n\ts_nop 0\n\tglobal_load_lds_dwordx4 %1, off\n\ts_mov_b32 m0, %0":"=&s"(keep):"v"(gsrc),"s"(lds_dst):"memory");}
__device__ __forceinline__ float max3f(float a,float b,float c){float r;asm("v_max3_f32 %0, %1, %2, %3":"=v"(r):"v"(a),"v"(b),"v"(c));return r;}
__device__ __forceinline__ float max2f(float a,float b){float r;asm("v_max_f32_e32 %0, %1, %2":"=v"(r):"v"(a),"v"(b));return r;}
__device__ __forceinline__ float fadd_s(float a,float b){float r;asm("v_add_f32_e32 %0, %1, %2":"=v"(r):"v"(a),"v"(b));return r;}
__device__ __forceinline__ float fsub_s(float a,float b){float r;asm("v_sub_f32_e32 %0, %1, %2":"=v"(r):"v"(a),"v"(b));return r;}
typedef float f32x2_t __attribute__((ext_vector_type(2))); typedef __bf16 bf16x2_t __attribute__((ext_vector_type(2)));
__device__ __forceinline__ unsigned cvtpk_s(float lo,float hi){f32x2_t v={lo,hi};bf16x2_t b=__builtin_convertvector(v,bf16x2_t);return __builtin_bit_cast(unsigned,b);}
#define WAIT_BAR(N) asm volatile("s_waitcnt vmcnt(" #N ") lgkmcnt(0)\n\ts_barrier":::"memory")

__device__ __forceinline__ void qkt(f32x16&p0,f32x16&p1,const char*Kslot,const bf16x8*qr,int r32,int hi){
  const char*kb=Kslot+hi*1024+r32*16;
  #pragma unroll
  for(int d0=0;d0<4;++d0){
    const bf16x8 b0=*reinterpret_cast<const bf16x8*>(kb+d0*2048);
    const bf16x8 b1=*reinterpret_cast<const bf16x8*>(kb+d0*2048+512);
    if(d0==0){p0=__builtin_amdgcn_mfma_f32_32x32x16_bf16(b0,qr[0],f32x16{},0,0,0);p1=__builtin_amdgcn_mfma_f32_32x32x16_bf16(b1,qr[0],f32x16{},0,0,0);}
    else{p0=__builtin_amdgcn_mfma_f32_32x32x16_bf16(b0,qr[d0],p0,0,0,0);p1=__builtin_amdgcn_mfma_f32_32x32x16_bf16(b1,qr[d0],p1,0,0,0);}}
}
typedef __attribute__((address_space(3))) const char* lds_cptr;
typedef short v4i16_t __attribute__((ext_vector_type(4)));
__device__ __forceinline__ void kload8(bf16x8*kf,lds_cptr kp){
  kf[0]=*(const __attribute__((address_space(3))) bf16x8*)(kp);      kf[1]=*(const __attribute__((address_space(3))) bf16x8*)(kp+512);
  kf[2]=*(const __attribute__((address_space(3))) bf16x8*)(kp+2048); kf[3]=*(const __attribute__((address_space(3))) bf16x8*)(kp+2560);
  kf[4]=*(const __attribute__((address_space(3))) bf16x8*)(kp+4096); kf[5]=*(const __attribute__((address_space(3))) bf16x8*)(kp+4608);
  kf[6]=*(const __attribute__((address_space(3))) bf16x8*)(kp+6144); kf[7]=*(const __attribute__((address_space(3))) bf16x8*)(kp+6656);
}
__device__ __forceinline__ void kload2(bf16x8*kf,lds_cptr kp,int j){ kf[2*j]=*(const __attribute__((address_space(3))) bf16x8*)(kp+j*2048); kf[2*j+1]=*(const __attribute__((address_space(3))) bf16x8*)(kp+j*2048+512); }
__device__ __forceinline__ s16x4 vtr(lds_cptr p){ return __builtin_bit_cast(s16x4,__builtin_amdgcn_ds_read_tr16_b64_v4i16((__attribute__((address_space(3))) v4i16_t*)p)); }
__device__ __forceinline__ float rowmax(const f32x16&p0,const f32x16&p1){
  float a=max3f(p0[0],p0[1],p1[0]),b=max3f(p0[2],p0[3],p1[1]);a=max3f(a,p1[2],p1[3]);
  #pragma unroll
  for(int r=4;r<16;r+=4){a=max3f(a,p0[r],p0[r+1]);b=max3f(b,p0[r+2],p0[r+3]);a=max3f(a,p1[r],p1[r+1]);b=max3f(b,p1[r+2],p1[r+3]);}
  const float m=max2f(a,b);
  auto rr=__builtin_amdgcn_permlane32_swap(__float_as_uint(m),__float_as_uint(m),false,false);
  return max2f(__uint_as_float(rr[0]),__uint_as_float(rr[1]));
}
__device__ __forceinline__ void pv(f32x16*o,int vb,bf16x8 pa0,bf16x8 pa1,bf16x8 pa2,bf16x8 pa3){
  #pragma unroll
  for(int d0=0;d0<2;++d0){s16x4 lo[4],hi[4];
    #pragma unroll
    for(int ks=0;ks<4;++ks){
      asm volatile("ds_read_b64_tr_b16 %0,%1 offset:%c2":"=&v"(lo[ks]):"v"(vb),"i"(d0*4096+ks*1024):"memory");
      asm volatile("ds_read_b64_tr_b16 %0,%1 offset:%c2":"=&v"(hi[ks]):"v"(vb),"i"(d0*4096+ks*1024+512):"memory");}
    asm volatile("s_waitcnt lgkmcnt(0)":::"memory");SBAR();
    #define PK(k) (bf16x8){lo[k][0],lo[k][1],lo[k][2],lo[k][3],hi[k][0],hi[k][1],hi[k][2],hi[k][3]}
    o[d0]=__builtin_amdgcn_mfma_f32_32x32x16_bf16(pa0,PK(0),o[d0],0,0,0);
    o[d0]=__builtin_amdgcn_mfma_f32_32x32x16_bf16(pa1,PK(1),o[d0],0,0,0);
    o[d0]=__builtin_amdgcn_mfma_f32_32x32x16_bf16(pa2,PK(2),o[d0],0,0,0);
    o[d0]=__builtin_amdgcn_mfma_f32_32x32x16_bf16(pa3,PK(3),o[d0],0,0,0);
    #undef PK
  }
}

#ifndef ATTN_STORE16
#define ATTN_STORE16(p,v) (*(u32x4*)(p)=(v))
#endif
template<int THRL,int MODE> __device__ __forceinline__ void attn_unit(int b,int qb,const bf16*Q,const bf16*__restrict__ K,const bf16*__restrict__ V,bf16*O,bf16*O2,char*shm,bf16*CM,float lam,const float*gn){
  int tid_=threadIdx.x; asm volatile("":"+v"(tid_)); const int tid=tid_,lane=tid&63,r32=lane&31,hi=lane>>5; const int wid=__builtin_amdgcn_readfirstlane(tid>>6);
  const long rowbase=(long)b*SEQ; const int q0=qb*QB;
  const bf16*Qw=Q+(rowbase+q0+wid*QBLK)*DM;
  const bf16*Kh=K+rowbase*DM,*Vh=V+rowbase*DM;
  const unsigned lds0=(unsigned)(uintptr_t)shm;
  float*wsf=(float*)(shm+LDS_WS)+wid*64;
  const bf16*ksrc=Kh+(long)lane*DM+wid*8;
  const bf16*vsrc=Vh+(long)(16*(wid&3)+(lane>>2))*DM+(wid>>2)*32+(lane&3)*8;
  const unsigned kdst=lds0+LDS_K+wid*1024, vdst=lds0+LDS_V+wid*1024;
  #define DMA_K(t,slot) glds16(ksrc+(long)(t)*KVBLK*DM,(unsigned)__builtin_amdgcn_readfirstlane(kdst+(slot)))
  #define DMA_V(t,slot) do{ glds16(vsrc+(long)(t)*KVBLK*DM,(unsigned)__builtin_amdgcn_readfirstlane(vdst+2*(slot))); glds16(vsrc+64+(long)(t)*KVBLK*DM,(unsigned)__builtin_amdgcn_readfirstlane(vdst+2*(slot)+8192)); }while(0)
  const int vb0=(int)(lds0+LDS_V)+((lane>>4)&1)*32+(lane&3)*8+(4*hi+((lane&15)>>2))*64;
  const char*Kbase=shm+LDS_K; bf16x8 kf[8];
  const lds_cptr shm3=(lds_cptr)shm; const lds_cptr kp0=shm3+LDS_K+hi*1024+r32*16; const lds_cptr vp0=shm3+LDS_V+((lane>>4)&1)*32+(lane&3)*8+(4*hi+((lane&15)>>2))*64;
  const int NT=(q0+QB)/KVBLK;
  DMA_K(0,0);DMA_V(0,0);DMA_K(1,SLOTB);
  bf16x8 qr[4];
  #pragma unroll
  for(int d0=0;d0<4;++d0)qr[d0]=*reinterpret_cast<const bf16x8*>(&Qw[(long)r32*DM+d0*16+hi*8]);
  float mhat=0.f,l_reg=0.f;f32x16 o[4];o[0]=f32x16{};o[1]=f32x16{};o[2]=f32x16{};o[3]=f32x16{};
  const int qrel=wid*QBLK+r32;
  #define CMASK(P0,P1,t) do{int jb_=(t)-(NT-4); if(jb_>=0)cmask(P0,P1,jb_,qrel,hi);}while(0)
  bool resc=false;
  #define START(P0,P1) do{ const float rm=rowmax(P0,P1); resc=false; mhat=fadd_s(mhat,rm); \
    _Pragma("unroll") for(int r=0;r<16;++r){P0[r]=fsub_s(P0[r],mhat);P1[r]=fsub_s(P1[r],mhat);} \
    _Pragma("unroll") for(int r=0;r<16;++r)P0[r]=__builtin_amdgcn_exp2f(P0[r]); }while(0)
  #define RESC() do{ if(resc){ asm volatile("s_waitcnt lgkmcnt(0)":::"memory"); \
      _Pragma("unroll") for(int d_=0;d_<4;++d_) _Pragma("unroll") for(int r=0;r<16;++r)o[d_][r]*=wsf[crow(r,hi)]; } }while(0)
  f32x16 pA0,pA1,pB0,pB1;
  int sl_prev=0,sl_cur=0,sl_next=SLOTB;
  #define ROT() do{sl_prev=sl_cur;sl_cur=sl_next;sl_next=(sl_next==(NSLOT-1)*SLOTB)?0:sl_next+SLOTB;}while(0)
  DMA_K(2,2*SLOTB);
  WAIT_BAR(4);
  qkt(pA0,pA1,Kbase,qr,r32,hi);asm volatile("s_nop 15\n\ts_nop 7":"+v"(pA0),"+v"(pA1));CMASK(pA0,pA1,0);
  START(pA0,pA1);
  _Pragma("unroll") for(int r=0;r<16;++r)pA1[r]=__builtin_amdgcn_exp2f(pA1[r]);
  WAIT_BAR(0);
  DMA_K(3,0);DMA_V(1,SLOTB);
  ROT();
  kload8(kf,kp0+sl_cur);
  WAIT_BAR(3);
  s16x4 vlo[8],vhi[8]; u32x4 pw0,pw1,pw2,pw3;
  #define PKW(P,B) cvtpk_s(P[B],P[B+1])
  #define PAF(k) __builtin_bit_cast(bf16x8,pw##k)
  #define VFR(i) (bf16x8){vlo[i][0],vlo[i][1],vlo[i][2],vlo[i][3],vhi[i][0],vhi[i][1],vhi[i][2],vhi[i][3]}
  #define PIN(x) asm volatile("":"+v"(x))
  #define MX3(a,b,c) __builtin_fmaxf(__builtin_fmaxf((a),(b)),(c))
  #define GAPA(MF,A0,A1,A2,A3,W0,W1,PW) do{ MF; sacc+=A0; sacc+=A1; sacc+=A2; sacc+=A3; PIN(sacc); W0; W1; PIN(PW); SBAR(); }while(0)
  #define EX(v) __builtin_amdgcn_exp2f(v)
  #define GAPB(MF,X,B) do{ MF; X[B]=EX(X[B]-mhat); X[B+1]=EX(X[B+1]-mhat); X[B+2]=EX(X[B+2]-mhat); X[B+3]=EX(X[B+3]-mhat); PIN(X); SBAR(); }while(0)
  #define GAPB2(MF,X,B) do{ MF; X[B]=EX(X[B]-mhat); X[B+1]=EX(X[B+1]-mhat); PIN(X); SBAR(); }while(0)
  #define VRD2(i) do{ vlo[i]=vtr(vp_+(8192+((i)>>2)*4096+((i)&3)*1024)); vhi[i]=vtr(vp_+(8192+((i)>>2)*4096+((i)&3)*1024+512)); SBAR(); }while(0)
  #define VRD(i) do{ vlo[i]=vtr(vp_+(((i)>>2)*4096+((i)&3)*1024)); vhi[i]=vtr(vp_+(((i)>>2)*4096+((i)&3)*1024+512)); }while(0)
  #define KRD(G,j) do{ if(G){ kload2(kf,kp0+sl_next,j); SBAR(); } }while(0)
  #define STEP(C0,C1,P0,P1,t,GK,GV,GL) do{ SBAR(); \
    const lds_cptr vp_=vp0+2*sl_prev; \
    VRD(0); SBAR(); float sacc=(P0[0]+P0[1]); \
    GAPA(C0=__builtin_amdgcn_mfma_f32_32x32x16_bf16(kf[0],qr[0],f32x16{},0,0,0), P0[2],P0[3],P0[4],P0[5],     pw0[0]=PKW(P0,0), pw0[1]=PKW(P0,2), pw0); \
    VRD(4); SBAR(); GAPA(C1=__builtin_amdgcn_mfma_f32_32x32x16_bf16(kf[1],qr[0],f32x16{},0,0,0), P0[6],P0[7],P0[8],P0[9],     pw0[2]=PKW(P0,4), pw0[3]=PKW(P0,6), pw0); \
    VRD(1); SBAR(); GAPA(C0=__builtin_amdgcn_mfma_f32_32x32x16_bf16(kf[2],qr[1],C0,0,0,0),   P0[10],P0[11],P0[12],P0[13], pw1[0]=PKW(P0,8), pw1[1]=PKW(P0,10), pw1); \
    VRD(5); SBAR(); GAPA(C1=__builtin_amdgcn_mfma_f32_32x32x16_bf16(kf[3],qr[1],C1,0,0,0),   P0[14],P0[15],P1[0],P1[1],   pw1[2]=PKW(P0,12),pw1[3]=PKW(P0,14), pw1); \
    VRD(2); SBAR(); GAPA(C0=__builtin_amdgcn_mfma_f32_32x32x16_bf16(kf[4],qr[2],C0,0,0,0),   P1[2],P1[3],P1[4],P1[5],     pw2[0]=PKW(P1,0), pw2[1]=PKW(P1,2), pw2); \
    VRD(6); SBAR(); GAPA(C1=__builtin_amdgcn_mfma_f32_32x32x16_bf16(kf[5],qr[2],C1,0,0,0),   P1[6],P1[7],P1[8],P1[9],     pw2[2]=PKW(P1,4), pw2[3]=PKW(P1,6), pw2); \
    VRD(3); SBAR(); GAPA(C0=__builtin_amdgcn_mfma_f32_32x32x16_bf16(kf[6],qr[3],C0,0,0,0),   P1[10],P1[11],P1[12],P1[13], pw3[0]=PKW(P1,8), pw3[1]=PKW(P1,10), pw3); \
    VRD(7); SBAR(); GAPA(C1=__builtin_amdgcn_mfma_f32_32x32x16_bf16(kf[7],qr[3],C1,0,0,0),   P1[14],P1[15],0.f,0.f,       pw3[2]=PKW(P1,12),pw3[3]=PKW(P1,14), pw3); \
    l_reg+=sacc; \
    if(GK){DMA_K((t)+3,sl_cur);} if(GV){DMA_V((t)+1,sl_next);} \
    CMASK(C0,C1,t); \
    { float a=MX3(C0[0],C0[1],C1[0]),b=MX3(C0[2],C0[3],C1[1]); a=MX3(a,C1[2],C1[3]); \
      _Pragma("unroll") for(int r=4;r<16;r+=4){a=MX3(a,C0[r],C0[r+1]);b=MX3(b,C0[r+2],C0[r+3]);a=MX3(a,C1[r],C1[r+1]);b=MX3(b,C1[r+2],C1[r+3]);} \
      float rm=__builtin_fmaxf(a,b); { auto rr=__builtin_amdgcn_permlane32_swap(__float_as_uint(rm),__float_as_uint(rm),false,false); rm=__builtin_fmaxf(__uint_as_float(rr[0]),__uint_as_float(rr[1])); } \
      resc=false; rm-=mhat; \
      if(__builtin_expect(__any(rm>(float)THRL),0)){ const float dl=__builtin_fmaxf(rm,0.f); mhat+=dl; \
        const float f=__builtin_amdgcn_exp2f(-dl); l_reg*=f; if(hi==0)wsf[r32]=f; resc=true; } } \
    SBAR(); \
    GAPB2(o[0]=__builtin_amdgcn_mfma_f32_32x32x16_bf16(PAF(0),VFR(0),o[0],0,0,0), C0,0); VRD2(0); \
    GAPB2(o[1]=__builtin_amdgcn_mfma_f32_32x32x16_bf16(PAF(0),VFR(4),o[1],0,0,0), C0,2); VRD2(4); \
    KRD(GL,0); GAPB2(o[0]=__builtin_amdgcn_mfma_f32_32x32x16_bf16(PAF(1),VFR(1),o[0],0,0,0), C0,4); VRD2(1); \
    KRD(GL,1); GAPB2(o[1]=__builtin_amdgcn_mfma_f32_32x32x16_bf16(PAF(1),VFR(5),o[1],0,0,0), C0,6); VRD2(5); \
    KRD(GL,2); GAPB2(o[0]=__builtin_amdgcn_mfma_f32_32x32x16_bf16(PAF(2),VFR(2),o[0],0,0,0), C0,8); VRD2(2); \
    KRD(GL,3); GAPB2(o[1]=__builtin_amdgcn_mfma_f32_32x32x16_bf16(PAF(2),VFR(6),o[1],0,0,0), C0,10); VRD2(6); \
    GAPB2(o[0]=__builtin_amdgcn_mfma_f32_32x32x16_bf16(PAF(3),VFR(3),o[0],0,0,0), C0,12); VRD2(3); \
    GAPB2(o[1]=__builtin_amdgcn_mfma_f32_32x32x16_bf16(PAF(3),VFR(7),o[1],0,0,0), C0,14); VRD2(7); \
    GAPB2(o[2]=__builtin_amdgcn_mfma_f32_32x32x16_bf16(PAF(0),VFR(0),o[2],0,0,0), C1,0); \
    GAPB2(o[3]=__builtin_amdgcn_mfma_f32_32x32x16_bf16(PAF(0),VFR(4),o[3],0,0,0), C1,2); \
    GAPB2(o[2]=__builtin_amdgcn_mfma_f32_32x32x16_bf16(PAF(1),VFR(1),o[2],0,0,0), C1,4); \
    GAPB2(o[3]=__builtin_amdgcn_mfma_f32_32x32x16_bf16(PAF(1),VFR(5),o[3],0,0,0), C1,6); \
    GAPB2(o[2]=__builtin_amdgcn_mfma_f32_32x32x16_bf16(PAF(2),VFR(2),o[2],0,0,0), C1,8); \
    GAPB2(o[3]=__builtin_amdgcn_mfma_f32_32x32x16_bf16(PAF(2),VFR(6),o[3],0,0,0), C1,10); \
    GAPB2(o[2]=__builtin_amdgcn_mfma_f32_32x32x16_bf16(PAF(3),VFR(3),o[2],0,0,0), C1,12); \
    GAPB2(o[3]=__builtin_amdgcn_mfma_f32_32x32x16_bf16(PAF(3),VFR(7),o[3],0,0,0), C1,14); \
    }while(0)
  int t=1;
  #undef CMASK
  #define CMASK(P0,P1,t) do{}while(0)
  for(;t+5<NT;t+=2){
    STEP(pB0,pB1,pA0,pA1,t,true,true,true);     WAIT_BAR(3); RESC(); ROT();
    STEP(pA0,pA1,pB0,pB1,t+1,true,true,true);   WAIT_BAR(3); RESC(); ROT();
  }
  #undef CMASK
  #define CMASK(P0,P1,t) do{int jb_=(t)-(NT-4); if(jb_>=0)cmask(P0,P1,jb_,qrel,hi);}while(0)
  #define ENDW(tt) do{ if((tt)+3<NT){WAIT_BAR(3);} else if((tt)+2<NT){WAIT_BAR(2);} else {WAIT_BAR(0);} }while(0)
  for(;t+1<NT;t+=2){
    STEP(pB0,pB1,pA0,pA1,t,(t+3<NT),(t+1<NT),(t+1<NT));       ENDW(t);   RESC(); ROT();
    STEP(pA0,pA1,pB0,pB1,t+1,(t+4<NT),(t+2<NT),(t+2<NT));     ENDW(t+1); RESC(); ROT();
  }
  STEP(pB0,pB1,pA0,pA1,NT-1,false,false,false); RESC();
  { float sacc=pB0[0]+pB0[1]; _Pragma("unroll") for(int r=2;r<16;++r)sacc+=pB0[r]; _Pragma("unroll") for(int r=0;r<16;++r)sacc+=pB1[r]; l_reg+=sacc;
    pw0=(u32x4){PKW(pB0,0),PKW(pB0,2),PKW(pB0,4),PKW(pB0,6)};pw1=(u32x4){PKW(pB0,8),PKW(pB0,10),PKW(pB0,12),PKW(pB0,14)};pw2=(u32x4){PKW(pB1,0),PKW(pB1,2),PKW(pB1,4),PKW(pB1,6)};pw3=(u32x4){PKW(pB1,8),PKW(pB1,10),PKW(pB1,12),PKW(pB1,14)};
    SBAR(); pv(o,vb0+2*sl_cur,PAF(0),PAF(1),PAF(2),PAF(3)); pv(o+2,vb0+2*sl_cur+8192,PAF(0),PAF(1),PAF(2),PAF(3)); }
  #undef PKW
  #undef PAF
  #undef VFR
  #undef PIN
  #undef MX3
  #undef GAPA
  #undef GAPB
  #undef GAPB2
  #undef EX
  #undef VRD
  #undef VRD2
  #undef KRD
  #undef STEP
  #undef ENDW
  {auto rr=__builtin_amdgcn_permlane32_swap(__float_as_uint(l_reg),__float_as_uint(l_reg),false,false);l_reg=__uint_as_float(rr[0])+__uint_as_float(rr[1]);}
  if(hi==0)wsf[32+r32]=l_reg;asm volatile("s_waitcnt lgkmcnt(0)":::"memory");
  float rli[16];
  #pragma unroll
  for(int r=0;r<16;++r)rli[r]=__builtin_amdgcn_rcpf(wsf[32+crow(r,hi)]);
  if constexpr(MODE==0){
  #pragma unroll
  for(int hf=0;hf<2;++hf){ bf16*Ow=(hf?O2:O)+(rowbase+q0+wid*QBLK)*DMO;
    bf16*stg=(bf16*)(shm+LDS_OST)+wid*2048;
    #pragma unroll
    for(int r=0;r<16;++r){const int orow=crow(r,hi);
      #pragma unroll
      for(int d0=0;d0<2;++d0)stg[orow*64+d0*32+r32]=__float2bfloat16(o[2*hf+d0][r]*rli[r]);}
    asm volatile("s_waitcnt lgkmcnt(0)":::"memory");
    #pragma unroll
    for(int i=0;i<4;++i){const int row=i*8+(lane>>3),ch=lane&7; const u32x4 v=*(const u32x4*)(stg+row*64+ch*8); ATTN_STORE16(Ow+(long)row*DMO+ch*8,v);}
    asm volatile("s_waitcnt lgkmcnt(0)":::"memory"); }
  } else {
  float dv[2][4][8]; float ssq[4]={0.f,0.f,0.f,0.f}; const int ch=lane&7;
  #pragma unroll
  for(int hf=0;hf<2;++hf){ const bf16*Aw=(hf?O2:O)+(rowbase+q0+wid*QBLK)*DMO;
    bf16*stg=(bf16*)(shm+LDS_OST)+wid*2048;
    #pragma unroll
    for(int r=0;r<16;++r){const int orow=crow(r,hi);
      #pragma unroll
      for(int d0=0;d0<2;++d0)stg[orow*64+d0*32+r32]=__float2bfloat16(o[2*hf+d0][r]*rli[r]);}
    asm volatile("s_waitcnt lgkmcnt(0)":::"memory");
    #pragma unroll
    for(int i=0;i<4;++i){const int row=i*8+(lane>>3); const u32x4 v=*(const u32x4*)(stg+row*64+ch*8); const u32x4 a=*(const u32x4*)(Aw+(long)row*DMO+ch*8);
      #pragma unroll
      for(int k=0;k<4;++k){ const float d0_=__uint_as_float(a[k]<<16)-lam*__uint_as_float(v[k]<<16), d1_=__uint_as_float(a[k]&0xffff0000u)-lam*__uint_as_float(v[k]&0xffff0000u);
        dv[hf][i][2*k]=d0_; dv[hf][i][2*k+1]=d1_; ssq[i]+=d0_*d0_+d1_*d1_; } }
    asm volatile("s_waitcnt lgkmcnt(0)":::"memory"); }
  float rs[4];
  #pragma unroll
  for(int i=0;i<4;++i){ float t_=ssq[i]; t_+=__shfl_xor(t_,1); t_+=__shfl_xor(t_,2); t_+=__shfl_xor(t_,4); rs[i]=__builtin_amdgcn_rsqf(t_*(1.f/128.f)+1e-6f); }
  #pragma unroll
  for(int hf=0;hf<2;++hf){ float g[8];
    #pragma unroll
    for(int e=0;e<8;++e)g[e]=gn[hf*64+ch*8+e];
    #pragma unroll
    for(int i=0;i<4;++i){const int row=i*8+(lane>>3); u32x4 w;
      #pragma unroll
      for(int k=0;k<4;++k)w[k]=cvtpk_s(dv[hf][i][2*k]*rs[i]*g[2*k],dv[hf][i][2*k+1]*rs[i]*g[2*k+1]);
      *(u32x4*)(CM+(rowbase+q0+wid*QBLK+row)*DMO+hf*64+ch*8)=w; } }
  }
  asm volatile("s_waitcnt lgkmcnt(0)\n\ts_barrier":::"memory");
  #undef DMA_K
  #undef DMA_V
  #undef CMASK
  #undef START
  #undef RESC
  #undef ROT
}
constexpr int ATTN_LDS_BYTES=LDS_BYTES;
template<int THRL=8> __device__ __forceinline__ void attn_phase(char*lds,const bf16*P,bf16*OA,bf16*CM,long SPLIT,float lam,const float*gn,int G,int vcu){
  if(G==256){ const int xcd=vcu>>5,c=vcu&31,s=c&7;
    for(int r=0;r<2;++r){ const int hp=xcd*8+4*r+(c>>3),b=hp>>3,h8=hp&7;
      for(int k=0;k<2;++k){ const int qb=k?s:15-s;
        attn_unit<THRL,0>(b,qb,P+(2*h8)*64,P+SPLIT+(2*h8)*64,P+2*SPLIT+h8*128,OA+h8*128,OA+h8*128+64,lds,nullptr,0.f,nullptr);
        attn_unit<THRL,1>(b,qb,P+(2*h8+1)*64,P+SPLIT+(2*h8+1)*64,P+2*SPLIT+h8*128,OA+h8*128,OA+h8*128+64,lds,CM+h8*128,lam,gn); } }
  } else {
    for(int u=vcu;u<BATCH*8*NQB;u+=G){ const int hp=u>>4,qb=NQB-1-(u&15),b=hp>>3,h8=hp&7;
      attn_unit<THRL,0>(b,qb,P+(2*h8)*64,P+SPLIT+(2*h8)*64,P+2*SPLIT+h8*128,OA+h8*128,OA+h8*128+64,lds,nullptr,0.f,nullptr);
      attn_unit<THRL,1>(b,qb,P+(2*h8+1)*64,P+SPLIT+(2*h8+1)*64,P+2*SPLIT+h8*128,OA+h8*128,OA+h8*128+64,lds,CM+h8*128,lam,gn); }
  }
}
#undef SBAR
#undef WAIT_BAR
}
namespace cg = cooperative_groups;
#ifndef PROBE_ID
#define PROBE_ID 0
#endif
#define LAS __attribute__((address_space(3)))
typedef unsigned short bf16;
typedef float f32x4 __attribute__((ext_vector_type(4)));
typedef float f32x2 __attribute__((ext_vector_type(2)));
typedef unsigned v4u __attribute__((ext_vector_type(4)));
typedef unsigned v2u __attribute__((ext_vector_type(2)));
typedef short bf16x8 __attribute__((ext_vector_type(8)));
typedef short bf16x4 __attribute__((ext_vector_type(4)));

#define XB_TMO      128
#define XB_XCNT(j)  (256  + 64 * (j))
#define XB_XSUB(j)  (1280 + 64 * (j))
#define XB_XGEN(j)  (2304 + 64 * (j))
#define XB_TOP      3328
#define XB_TOPGEN   3392
#define XCD_BAR_WORDS 3456
#define XB_SPIN_CAP (1u << 18)

__device__ __forceinline__ unsigned xb_ld(unsigned* p)              { return __hip_atomic_load(p, __ATOMIC_RELAXED, __HIP_MEMORY_SCOPE_AGENT); }
__device__ __forceinline__ unsigned xb_add(unsigned* p, unsigned v) { return __hip_atomic_fetch_add(p, v, __ATOMIC_RELAXED, __HIP_MEMORY_SCOPE_AGENT); }
__device__ __forceinline__ unsigned xb_xcc_id() { return (unsigned)__builtin_amdgcn_s_getreg((3 << 11) | 20) & 0xFu; }
#define XB_SPIN(cond, bar) do { unsigned _sp = 0; while (cond) { __builtin_amdgcn_s_sleep(1); \
    if ((++_sp & 255u) == 0u) { if (xb_ld(&(bar)[XB_TMO])) break; if (_sp > XB_SPIN_CAP) { atomicAdd(&(bar)[XB_TMO], 1u); break; } } } } while (0)

struct XcdBarrier {
    unsigned* bar; unsigned x;
    volatile LAS unsigned* st;
};

__device__ __forceinline__ XcdBarrier xcd_barrier_post(unsigned* bar, volatile LAS unsigned* st) {
    XcdBarrier b; b.bar = bar; b.x = xb_xcc_id(); b.st = st;
    if (threadIdx.x == 0) (void)xb_add(&bar[XB_XCNT(b.x)], 1u);
    return b;
}
__device__ __forceinline__ void xcd_barrier_complete(unsigned* bar, unsigned x, unsigned& nloc, unsigned& nx) {
    const unsigned G = gridDim.x * gridDim.y * gridDim.z;
    unsigned sum, cnt, mine, sp = 0u;
    for (;;) {
        sum = 0u; cnt = 0u; mine = 0u;
#pragma unroll
        for (unsigned j = 0; j < 16; ++j) { const unsigned c = xb_ld(&bar[XB_XCNT(j)]); sum += c; cnt += (c > 0u) ? 1u : 0u; mine = (j == x) ? c : mine; }
        if (sum == G) break;
        __builtin_amdgcn_s_sleep(1);
        if ((++sp & 255u) == 0u) { if (xb_ld(&bar[XB_TMO])) break; if (sp > XB_SPIN_CAP) { atomicAdd(&bar[XB_TMO], 1u); break; } }
    }
    nloc = mine > 0u ? mine : 1u; nx = cnt > 0u ? cnt : 1u;
}

__device__ __forceinline__ void xcd_barrier(const XcdBarrier& b) {
    asm volatile("s_waitcnt vmcnt(0)" ::: "memory");
    __syncthreads();
    if (threadIdx.x == 0) {
        unsigned* bar = b.bar;
        __builtin_amdgcn_s_waitcnt(0);
        unsigned nloc = b.st[0], nx = b.st[1];
        if (nloc == 0u) { xcd_barrier_complete(bar, b.x, nloc, nx); b.st[0] = nloc; b.st[1] = nx; }
        const unsigned old = xb_add(&bar[XB_XSUB(b.x)], 1u);
        const unsigned gen = old / nloc;
        if (old + 1u == (gen + 1u) * nloc) {
            __builtin_amdgcn_fence(__ATOMIC_RELEASE, "agent");
            asm volatile("s_waitcnt vmcnt(0)" ::: "memory");
            const unsigned og = xb_add(&bar[XB_TOP], 1u);
            const unsigned tg = og / nx;
            if (og + 1u == (tg + 1u) * nx) xb_add(&bar[XB_TOPGEN], 1u);
            else XB_SPIN(xb_ld(&bar[XB_TOPGEN]) == tg, bar);
            __builtin_amdgcn_fence(__ATOMIC_ACQUIRE, "agent");
            xb_add(&bar[XB_XGEN(b.x)], 1u);
            asm volatile("s_waitcnt vmcnt(0)" ::: "memory");
        } else {
            XB_SPIN(xb_ld(&bar[XB_XGEN(b.x)]) == gen, bar);
            __builtin_amdgcn_fence(__ATOMIC_ACQUIRE, "agent");
            asm volatile("s_waitcnt vmcnt(0)" ::: "memory");
        }
    }
    __syncthreads();
}

constexpr int NWAVES = 8, NTHR = 512;
constexpr int M = 32768, DM_ = 1024, SEQL = 4096, FF = 2816, NIN = 29;
constexpr float EPS = 1e-6f;
constexpr size_t MiB = 1u << 20;
constexpr size_t WS_CTL = 0, CTL_ZERO_BYTES = 65536, WS_BAR = 16384, WS_SSP = 88 * MiB;
constexpr int MISC_OFF = 131072;
constexpr size_t WS_GN = 3 * MiB;
constexpr size_t WS_CS = 1 * MiB, WS_KMAT = 2 * MiB, WS_W1T = 4 * MiB, WS_WYT = 12 * MiB;
constexpr size_t WS_WIN = 32 * MiB, WS_WOUT = 37 * MiB, WS_WGLU = 39 * MiB, WS_WQKV = 40 * MiB, WS_WO = 46 * MiB, WS_WGU = 48 * MiB, WS_WDN = 70 * MiB, WS_WPP = 81 * MiB, WS_WPG = 82 * MiB;
constexpr size_t SZ_WGU = 11 * MiB, SZ_WDN = 5632 * 1024, SZ_WPP = 512 * 1024, SZ_WPG = 2 * MiB;
constexpr size_t WS_PB = 92 * MiB, WS_HN = 124 * MiB, WS_PP = 188 * MiB, WS_MIX = 252 * MiB, WS_PROJ = 316 * MiB, WS_END = 508 * MiB;
constexpr size_t WS_Y = WS_HN, WS_OATT = WS_HN, WS_KV = WS_PP, WS_RT = WS_PP + 32 * MiB, WS_SLOC = WS_PP + 48 * MiB, WS_UX = WS_PROJ + 128 * MiB, WS_ACT = WS_PROJ;
constexpr int LDS_BYTES = 147456;
constexpr float C2Q = 0.125f * 1.4426950408889634f;

__device__ __forceinline__ unsigned f2bf(float f) { unsigned u = __builtin_bit_cast(unsigned, f); return (u + 0x7fffu + ((u >> 16) & 1u)) >> 16; }
__device__ __forceinline__ unsigned pk2(float lo, float hi) { return f2bf(lo) | (f2bf(hi) << 16); }
__device__ __forceinline__ float bflo(unsigned w) { return __uint_as_float(w << 16); }
__device__ __forceinline__ float bfhi(unsigned w) { return __uint_as_float(w & 0xffff0000u); }
__device__ __forceinline__ void rstd8(const float* ss, int row0, int fq, float (&rs)[8]) {
    f32x4 a[8];
#pragma unroll
    for (int k = 0; k < 8; ++k) a[k] = *(const f32x4*)(ss + (size_t)(row0 + (k >> 2) * 128 + (k & 3) * 16) * 16 + 4 * fq);
#pragma unroll
    for (int k = 0; k < 8; ++k) { float s = (a[k][0] + a[k][1]) + (a[k][2] + a[k][3]); s += __shfl_xor(s, 16); s += __shfl_xor(s, 32); rs[k] = __builtin_amdgcn_rsqf(s * (1.f / 1024.f) + EPS); }
}
__device__ __forceinline__ float rstd_row(const float* ss, int row) { const f32x4* p = (const f32x4*)(ss + (size_t)row * 16); const f32x4 a = p[0], b = p[1], c = p[2], d = p[3];
    const float s = (((a[0] + a[1]) + (a[2] + a[3])) + ((b[0] + b[1]) + (b[2] + b[3]))) + (((c[0] + c[1]) + (c[2] + c[3])) + ((d[0] + d[1]) + (d[2] + d[3]))); return __builtin_amdgcn_rsqf(s * (1.f / 1024.f) + EPS); }
__device__ __forceinline__ float sigm(float x) { return __builtin_amdgcn_rcpf(1.f + __expf(-x)); }
__device__ __forceinline__ float wave_sum(float v) {
#pragma unroll
    for (int o = 1; o < 64; o <<= 1) v += __shfl_xor(v, o);
    return v;
}
__device__ __forceinline__ void sincos_rad(float x, float& s, float& c) {
    double r = (double)x * 0.15915494309189535; r -= __builtin_rint(r); const float fr = (float)r;
    s = __builtin_amdgcn_sinf(fr); c = __builtin_amdgcn_cosf(fr);
}
__device__ __forceinline__ void cpow(float lr, float li, float delta, float j, float& re, float& im) {
    const float mag = expf(j * delta * lr); float s, c; sincos_rad(j * delta * li, s, c); re = mag * c; im = mag * s;
}
__device__ __forceinline__ float gelu_tanh(float v) { const float z = 1.5957691216057308f * (v + 0.044715f * v * v * v); return v * sigm(z); }

using pg8::Unit; using pg8::HALF; using pg8::BM; using pg8::cvt_pk_bf16;
template <int LAYER> struct EpiProj {
    static constexpr bool PERM = true, AFTER_DRAIN = false;
    static constexpr int ldc = LAYER ? 1024 : 2048, tps = LAYER ? 4 : (1 << 20), rope_tiles = LAYER ? 8 : 4, sc_lo = LAYER ? 0 : 2, sc_hi = 4, ux_tile = LAYER ? (1 << 30) : 8;
    static constexpr size_t sstride = (size_t)M * 1024; static constexpr float sc = LAYER ? C2Q : 0.125f;
    bf16* O; const float* cs; bf16* UX; const float* ss;
    __device__ __forceinline__ void operator()(const pg8::f32x4 (&acc)[2][2][4][2], const Unit& u, int wr, int wc, int fr, int fq) const {
        const int pn = u.pn; const int row0 = u.pm * BM + wr * 64 + fr; const int sp = pn / tps, pt = pn - sp * tps; bf16* const Ob = O + (size_t)sp * sstride;
        float rsv[8]; rstd8(ss, row0, fq, rsv);
        if (pn < rope_tiles) {
            const float s_ = (pn >= sc_lo && pn < sc_hi) ? sc : 1.f;
            const int i0 = 16 * (wc & 1) + 4 * fq;
            f32x4 cN = *(const f32x4*)(cs + (row0 & (SEQL - 1)) * 64 + i0), sN = *(const f32x4*)(cs + (row0 & (SEQL - 1)) * 64 + 32 + i0);
#pragma unroll
            for (int k = 0; k < 8; ++k) { const int ai = k >> 2, m = k & 3; const int row = row0 + ai * HALF + m * 16; const float s = s_ * rsv[k];
                const f32x4 c = cN, sn = sN;
                if (k < 7) { const int rown = row0 + ((k + 1) >> 2) * HALF + ((k + 1) & 3) * 16, posn = rown & (SEQL - 1); cN = *(const f32x4*)(cs + posn * 64 + i0); sN = *(const f32x4*)(cs + posn * 64 + 32 + i0); }
#pragma unroll
                for (int bj = 0; bj < 2; ++bj) { const f32x4 x1 = acc[ai][bj][m][0], x2 = acc[ai][bj][m][1];
                    const f32x4 o1 = (x1 * c - x2 * sn) * s, o2 = (x2 * c + x1 * sn) * s;
                    bf16* p = Ob + (size_t)row * ldc + pt * BM + bj * HALF + 64 * (wc >> 1) + i0;
                    v2u w1, w2; w1.x = cvt_pk_bf16(o1[0], o1[1]); w1.y = cvt_pk_bf16(o1[2], o1[3]); w2.x = cvt_pk_bf16(o2[0], o2[1]); w2.y = cvt_pk_bf16(o2[2], o2[3]);
                    *(v2u*)p = w1; *(v2u*)(p + 32) = w2; } }
        } else if (pn < ux_tile) {
#pragma unroll
            for (int ai = 0; ai < 2; ++ai)
#pragma unroll
                for (int m = 0; m < 4; ++m) { const int row = row0 + ai * HALF + m * 16; const float rs = rsv[ai * 4 + m];
#pragma unroll
                    for (int bj = 0; bj < 2; ++bj) { const f32x4 v0 = acc[ai][bj][m][0] * rs, v1 = acc[ai][bj][m][1] * rs;
                        v4u w; w.x = cvt_pk_bf16(v0[0], v0[1]); w.y = cvt_pk_bf16(v0[2], v0[3]); w.z = cvt_pk_bf16(v1[0], v1[1]); w.w = cvt_pk_bf16(v1[2], v1[3]);
                        *(v4u*)(Ob + (size_t)row * ldc + pt * BM + bj * HALF + wc * 32 + 8 * fq) = w; } }
        } else {
#pragma unroll
            for (int ai = 0; ai < 2; ++ai)
#pragma unroll
                for (int m = 0; m < 4; ++m) { const int row = row0 + ai * HALF + m * 16; const float rs = rsv[ai * 4 + m];
#pragma unroll
                    for (int bj = 0; bj < 2; ++bj) { const f32x4 v0 = acc[ai][bj][m][0] * rs, v1 = acc[ai][bj][m][1] * rs;
                        v4u w; w.x = cvt_pk_bf16(v0[0], v0[1]); w.y = cvt_pk_bf16(v0[2], v0[3]); w.z = cvt_pk_bf16(v1[0], v1[1]); w.w = cvt_pk_bf16(v1[2], v1[3]);
                        const int ch = (pn - ux_tile) * BM + bj * HALF + wc * 32 + 8 * fq, g = ch >> 4, c0 = ch & 15;
                        *(v4u*)(UX + ((size_t)g * 1024 + (row >> 5)) * 640 + (row & 31) * 16 + c0) = w; } }
        }
    }
};
struct EpiPlain {
    static constexpr bool PERM = true, AFTER_DRAIN = false;
    bf16* O;
    __device__ __forceinline__ void operator()(const pg8::f32x4 (&acc)[2][2][4][2], const Unit& u, int wr, int wc, int fr, int fq) const {
        const int row0 = u.pm * BM + wr * 64 + fr, col0 = u.pn * BM + wc * 32 + 8 * fq;
#pragma unroll
        for (int ai = 0; ai < 2; ++ai)
#pragma unroll
            for (int m = 0; m < 4; ++m)
#pragma unroll
                for (int bj = 0; bj < 2; ++bj) { const pg8::f32x4 v0 = acc[ai][bj][m][0], v1 = acc[ai][bj][m][1];
                    v4u w; w.x = cvt_pk_bf16(v0[0], v0[1]); w.y = cvt_pk_bf16(v0[2], v0[3]); w.z = cvt_pk_bf16(v1[0], v1[1]); w.w = cvt_pk_bf16(v1[2], v1[3]);
                    *(v4u*)(O + (size_t)(row0 + ai * HALF + m * 16) * DM_ + col0 + bj * HALF) = w; }
    }
};
template <bool BASEF32> struct EpiRes {
    static constexpr bool PERM = true, AFTER_DRAIN = false;
    const void* base; bf16* out; float* ssq;
    struct Ld { f32x4 a[2][2]; };
    __device__ __forceinline__ void ld(Ld& L, size_t o) const {
#pragma unroll
        for (int bj = 0; bj < 2; ++bj) { if (BASEF32) { L.a[bj][0] = *(const f32x4*)((const float*)base + o + bj * HALF); L.a[bj][1] = *(const f32x4*)((const float*)base + o + bj * HALF + 4); }
            else { const v4u w = *(const v4u*)((const bf16*)base + o + bj * HALF); L.a[bj][0] = __builtin_bit_cast(f32x4, w); } }
    }
    __device__ __forceinline__ void operator()(const pg8::f32x4 (&acc)[2][2][4][2], const Unit& u, int wr, int wc, int fr, int fq) const {
        const int row0 = u.pm * BM + wr * 64 + fr, col0 = u.pn * BM + wc * 32 + 8 * fq;
        Ld nx; ld(nx, (size_t)row0 * DM_ + col0);
#pragma unroll
        for (int k = 0; k < 8; ++k) { const int ai = k >> 2, m = k & 3; const int row = row0 + ai * HALF + m * 16; float q = 0.f; const Ld cu = nx;
            if (k < 7) ld(nx, (size_t)(row0 + ((k + 1) >> 2) * HALF + ((k + 1) & 3) * 16) * DM_ + col0);
#pragma unroll
            for (int bj = 0; bj < 2; ++bj) { const size_t o = (size_t)row * DM_ + col0 + bj * HALF; f32x4 b0, b1;
                if (BASEF32) { b0 = cu.a[bj][0]; b1 = cu.a[bj][1]; }
                else { const v4u w = __builtin_bit_cast(v4u, cu.a[bj][0]); b0 = (f32x4){bflo(w.x), bfhi(w.x), bflo(w.y), bfhi(w.y)}; b1 = (f32x4){bflo(w.z), bfhi(w.z), bflo(w.w), bfhi(w.w)}; }
                const f32x4 r0 = b0 + acc[ai][bj][m][0], r1 = b1 + acc[ai][bj][m][1];
                q += (r0[0] * r0[0] + r0[1] * r0[1]) + (r0[2] * r0[2] + r0[3] * r0[3]) + (r1[0] * r1[0] + r1[1] * r1[1]) + (r1[2] * r1[2] + r1[3] * r1[3]);
                v4u w; w.x = cvt_pk_bf16(r0[0], r0[1]); w.y = cvt_pk_bf16(r0[2], r0[3]); w.z = cvt_pk_bf16(r1[0], r1[1]); w.w = cvt_pk_bf16(r1[2], r1[3]); *(v4u*)(out + o) = w; }
            q += __shfl_xor(q, 16); q += __shfl_xor(q, 32); if (fq == 0) ssq[(size_t)row * 16 + u.pn * 4 + wc] = q; }
    }
};
struct EpiPle {
    static constexpr bool PERM = true, AFTER_DRAIN = false;
    const bf16* pp; const bf16* base; const float* ss; bf16* out; float* ssq;
    __device__ __forceinline__ void operator()(const pg8::f32x4 (&acc)[2][2][4][2], const Unit& u, int wr, int wc, int fr, int fq) const {
        const int row0 = u.pm * BM + wr * 64 + fr, col0 = u.pn * BM + wc * 32 + 8 * fq;
        float rsv[8]; rstd8(ss, row0, fq, rsv);
        v4u nb[2], np[2];
#pragma unroll
        for (int bj = 0; bj < 2; ++bj) { const size_t o = (size_t)row0 * DM_ + col0 + bj * HALF; nb[bj] = *(const v4u*)(base + o); np[bj] = *(const v4u*)(pp + o); }
#pragma unroll
        for (int k = 0; k < 8; ++k) { const int ai = k >> 2, m = k & 3; const int row = row0 + ai * HALF + m * 16; const float rs = rsv[k]; float q = 0.f;
            v4u cb[2], cp[2];
#pragma unroll
            for (int bj = 0; bj < 2; ++bj) { cb[bj] = nb[bj]; cp[bj] = np[bj]; }
            if (k < 7) {
#pragma unroll
                for (int bj = 0; bj < 2; ++bj) { const size_t o = (size_t)(row0 + ((k + 1) >> 2) * HALF + ((k + 1) & 3) * 16) * DM_ + col0 + bj * HALF; nb[bj] = *(const v4u*)(base + o); np[bj] = *(const v4u*)(pp + o); } }
#pragma unroll
            for (int bj = 0; bj < 2; ++bj) { const size_t o = (size_t)row * DM_ + col0 + bj * HALF; const v4u bw = cb[bj], pw = cp[bj];
                const float c1 = -1.4426950408889634f * rs; float r[8];
#define PLE2(kk, A, e0, BW, PW) { const f32x2 t = (f32x2){A[e0], A[e0 + 1]} * c1; f32x2 d; d.x = __builtin_amdgcn_exp2f(t.x); d.y = __builtin_amdgcn_exp2f(t.y); d = d + 1.0f; \
                    f32x2 q2; q2.x = __builtin_amdgcn_rcpf(d.x); q2.y = __builtin_amdgcn_rcpf(d.y); const f32x2 o2 = (f32x2){bflo(BW), bfhi(BW)} + (f32x2){bflo(PW), bfhi(PW)} * q2; r[kk] = o2.x; r[kk + 1] = o2.y; }
                { const f32x4 a0 = acc[ai][bj][m][0], a1 = acc[ai][bj][m][1];
                  PLE2(0, a0, 0, bw.x, pw.x) PLE2(2, a0, 2, bw.y, pw.y) PLE2(4, a1, 0, bw.z, pw.z) PLE2(6, a1, 2, bw.w, pw.w) }
#undef PLE2
#pragma unroll
                for (int e = 0; e < 8; ++e) q += r[e] * r[e];
                v4u w; w.x = cvt_pk_bf16(r[0], r[1]); w.y = cvt_pk_bf16(r[2], r[3]); w.z = cvt_pk_bf16(r[4], r[5]); w.w = cvt_pk_bf16(r[6], r[7]); *(v4u*)(out + o) = w; }
            q += __shfl_xor(q, 16); q += __shfl_xor(q, 32); if (fq == 0) ssq[(size_t)row * 16 + u.pn * 4 + wc] = q; }
    }
};
struct EpiSwiglu {
    static constexpr bool PERM = true, AFTER_DRAIN = false;
    bf16* O; const float* ss;
    __device__ __forceinline__ void operator()(const pg8::f32x4 (&acc)[2][2][4][2], const Unit& u, int wr, int wc, int fr, int fq) const {
        const int row0 = u.pm * BM + wr * 64 + fr, col0 = u.pn * HALF + wc * 32 + 8 * fq;
        float rsv[8]; rstd8(ss, row0, fq, rsv);
#pragma unroll
        for (int ai = 0; ai < 2; ++ai)
#pragma unroll
            for (int m = 0; m < 4; ++m) { float r[8]; const float rs = rsv[ai * 4 + m]; const float c1 = -1.4426950408889634f * rs, rs2 = rs * rs;
#pragma unroll
                for (int n = 0; n < 2; ++n)
#pragma unroll
                    for (int e = 0; e < 4; e += 2) { const f32x2 ag = {acc[ai][0][m][n][e], acc[ai][0][m][n][e + 1]}, au = {acc[ai][1][m][n][e], acc[ai][1][m][n][e + 1]};
                        const f32x2 t = ag * c1; f32x2 d; d.x = __builtin_amdgcn_exp2f(t.x); d.y = __builtin_amdgcn_exp2f(t.y); d = d + 1.0f;
                        f32x2 q; q.x = __builtin_amdgcn_rcpf(d.x); q.y = __builtin_amdgcn_rcpf(d.y); const f32x2 o = (ag * au) * rs2 * q; r[4 * n + e] = o.x; r[4 * n + e + 1] = o.y; }
                v4u w; w.x = cvt_pk_bf16(r[0], r[1]); w.y = cvt_pk_bf16(r[2], r[3]); w.z = cvt_pk_bf16(r[4], r[5]); w.w = cvt_pk_bf16(r[6], r[7]);
                __builtin_nontemporal_store(w, (v4u*)(O + (size_t)(row0 + ai * HALF + m * 16) * FF + col0)); }
    }
};
struct EpiGlu {
    static constexpr bool PERM = true, AFTER_DRAIN = false;
    const bf16* Y; bf16* O;
    __device__ __forceinline__ void operator()(const pg8::f32x4 (&acc)[2][2][4][2], const Unit& u, int wr, int wc, int fr, int fq) const {
        const int row0 = u.pm * BM + wr * 64 + fr, col0 = u.pn * BM + wc * 32 + 8 * fq;
        v4u ny[2];
#pragma unroll
        for (int bj = 0; bj < 2; ++bj) ny[bj] = *(const v4u*)(Y + (size_t)row0 * 512 + col0 + bj * HALF);
#pragma unroll
        for (int k = 0; k < 8; ++k) { const int ai = k >> 2, m = k & 3; const int row = row0 + ai * HALF + m * 16; v4u cy[2];
#pragma unroll
            for (int bj = 0; bj < 2; ++bj) cy[bj] = ny[bj];
            if (k < 7) {
#pragma unroll
                for (int bj = 0; bj < 2; ++bj) ny[bj] = *(const v4u*)(Y + (size_t)(row0 + ((k + 1) >> 2) * HALF + ((k + 1) & 3) * 16) * 512 + col0 + bj * HALF); }
#pragma unroll
            for (int bj = 0; bj < 2; ++bj) { const int col = col0 + bj * HALF; const v4u yw = cy[bj]; const f32x4 a0 = acc[ai][bj][m][0], a1 = acc[ai][bj][m][1];
                v4u w; w.x = cvt_pk_bf16(bflo(yw.x) * sigm(a0[0]), bfhi(yw.x) * sigm(a0[1])); w.y = cvt_pk_bf16(bflo(yw.y) * sigm(a0[2]), bfhi(yw.y) * sigm(a0[3]));
                w.z = cvt_pk_bf16(bflo(yw.z) * sigm(a1[0]), bfhi(yw.z) * sigm(a1[1])); w.w = cvt_pk_bf16(bflo(yw.w) * sigm(a1[2]), bfhi(yw.w) * sigm(a1[3]));
                *(v4u*)(O + (size_t)row * DM_ + 512 + col) = w; } }
    }
};
struct EpiSloc {
    static constexpr bool PERM = false, AFTER_DRAIN = false;
    float* S;
    __device__ __forceinline__ void operator()(const pg8::f32x4 (&acc)[2][2][4][2], const Unit& u, int wr, int wc, int fr, int fq) const {
        const int row0 = u.pm * BM + wr * 64 + fr, col0 = wc * 32 + 4 * fq;
#pragma unroll
        for (int ai = 0; ai < 2; ++ai)
#pragma unroll
            for (int m = 0; m < 4; ++m) { float* p = S + ((size_t)u.g * 1024 + row0 + ai * HALF + m * 16) * 128 + col0;
#pragma unroll
                for (int n = 0; n < 2; ++n) *(f32x4*)(p + n * 16) = acc[ai][0][m][n]; }
    }
};
struct EpiS5Y {
    static constexpr bool PERM = true, AFTER_DRAIN = false;
    const bf16* UX; bf16* Y; const float* dsk;
    __device__ __forceinline__ void operator()(const pg8::f32x4 (&acc)[2][2][4][2], const Unit& u, int wr, int wc, int fr, int fq) const {
        const int row0 = u.pm * BM + wr * 64 + fr; const int c0 = 8 * (fq & 1);
        const f32x4 d0 = *(const f32x4*)(dsk + u.g * 16 + c0), d1 = *(const f32x4*)(dsk + u.g * 16 + c0 + 4);
        const int colb = u.pn * BM + wc * 32 + 8 * fq;
        v4u nu[2];
#pragma unroll
        for (int bj = 0; bj < 2; ++bj) nu[bj] = *(const v4u*)(UX + ((size_t)u.g * 1024 + row0) * 640 + ((colb + bj * HALF) >> 4) * 16 + c0);
#pragma unroll
        for (int k = 0; k < 8; ++k) { const int ai = k >> 2, m = k & 3; const int row = row0 + ai * HALF + m * 16; v4u cu[2];
#pragma unroll
            for (int bj = 0; bj < 2; ++bj) cu[bj] = nu[bj];
            if (k < 7) {
#pragma unroll
                for (int bj = 0; bj < 2; ++bj) nu[bj] = *(const v4u*)(UX + ((size_t)u.g * 1024 + row0 + ((k + 1) >> 2) * HALF + ((k + 1) & 3) * 16) * 640 + ((colb + bj * HALF) >> 4) * 16 + c0); }
#pragma unroll
            for (int bj = 0; bj < 2; ++bj) { const int tau = (colb + bj * HALF) >> 4;
                const v4u uw = cu[bj]; const f32x4 a0 = acc[ai][bj][m][0], a1 = acc[ai][bj][m][1];
                float r[8]; r[0] = a0[0] + d0[0] * bflo(uw.x); r[1] = a0[1] + d0[1] * bfhi(uw.x); r[2] = a0[2] + d0[2] * bflo(uw.y); r[3] = a0[3] + d0[3] * bfhi(uw.y);
                r[4] = a1[0] + d1[0] * bflo(uw.z); r[5] = a1[1] + d1[1] * bfhi(uw.z); r[6] = a1[2] + d1[2] * bflo(uw.w); r[7] = a1[3] + d1[3] * bfhi(uw.w);
#pragma unroll
                for (int e = 0; e < 8; ++e) r[e] = gelu_tanh(r[e]);
                v4u w; w.x = cvt_pk_bf16(r[0], r[1]); w.y = cvt_pk_bf16(r[2], r[3]); w.z = cvt_pk_bf16(r[4], r[5]); w.w = cvt_pk_bf16(r[6], r[7]);
                *(v4u*)(Y + ((size_t)row * 32 + tau) * 512 + u.g * 16 + c0) = w; } }
    }
};
struct GroupOrder {
    int nM, nN, ng, G, c;
    __device__ __forceinline__ bool next(int i, Unit& u) const { const int L = i * G + c; if (L >= nM * nN * ng) return false; const int per = nM * nN, r = L % per; u.g = L / per; u.pn = r / nM; u.pm = r % nM; return true; }
    __device__ __forceinline__ void a_ready(const Unit&) const {}
    __device__ __forceinline__ void done(const Unit&) const {}
};

struct Frame { LAS unsigned char* lds; int tid, lane, wave, G, bx, gw, NGW; };

__device__ __forceinline__ int maprow(int mode, int lim, int n) {
    if (mode == 1) { if (n >= lim) return n; const int i = n & 63, ii = i & 31; return (n & ~63) + 32 * (ii >> 4) + 8 * ((ii >> 2) & 3) + 4 * (i >> 5) + (ii & 3); }
    if (mode == 2) return 256 * (n >> 7) + (n & 127);
    if (mode == 3) return 256 * (n >> 7) + 128 + (n & 127);
    return n;
}
template <bool HAS_GAIN> __device__ __forceinline__ void transpose_item(const float* W, int K, int N, bf16* WT, int mode, int lim, LAS float* scr, int item, int lane, const float* gain) {
    const int nblk = N / 32, kb = item / nblk, nb = item % nblk, k0 = 64 * kb, n0 = 32 * nb;
    const float* src = W + (size_t)(k0 + (lane >> 5)) * N + n0 + (lane & 31);
    float v[32];
#pragma unroll
    for (int i = 0; i < 32; ++i) v[i] = __builtin_nontemporal_load(src + (size_t)(2 * i) * N);
    const int c = lane & 7;
    f32x4 ga = {1.f, 1.f, 1.f, 1.f}, gb = {1.f, 1.f, 1.f, 1.f};
    if (HAS_GAIN) { ga = *(const f32x4*)(gain + k0 + 8 * c); gb = *(const f32x4*)(gain + k0 + 8 * c + 4); }
#pragma unroll
    for (int i = 0; i < 32; ++i) scr[(2 * i + (lane >> 5)) * 33 + (lane & 31)] = v[i];
    asm volatile("s_waitcnt lgkmcnt(0)" ::: "memory");
#pragma unroll
    for (int j = 0; j < 4; ++j) { const int n = (lane >> 3) + 8 * j; const LAS float* s = scr + (8 * c) * 33 + n;
        v4u o; o.x = pk2(s[0 * 33] * ga[0], s[1 * 33] * ga[1]); o.y = pk2(s[2 * 33] * ga[2], s[3 * 33] * ga[3]); o.z = pk2(s[4 * 33] * gb[0], s[5 * 33] * gb[1]); o.w = pk2(s[6 * 33] * gb[2], s[7 * 33] * gb[3]);
        *(v4u*)(WT + (size_t)maprow(mode, lim, n0 + n) * K + k0 + 8 * c) = o; }
    asm volatile("s_waitcnt lgkmcnt(0)" ::: "memory");
}
__device__ __forceinline__ void final_norm_phase(const Frame& F, const bf16* h, const float* ssq, const float* gain, float* out) {
    for (int it = F.bx * NTHR + F.tid; it < M * 128; it += F.G * NTHR) { const int row = it >> 7, c8 = (it & 127) * 8; const float rs = rstd_row(ssq, row);
        const v4u w = *(const v4u*)(h + (size_t)row * DM_ + c8); const f32x4 g0 = *(const f32x4*)(gain + c8), g1 = *(const f32x4*)(gain + c8 + 4);
        float* o = out + (size_t)row * DM_ + c8;
        __builtin_nontemporal_store((f32x4){bflo(w.x) * rs * g0[0], bfhi(w.x) * rs * g0[1], bflo(w.y) * rs * g0[2], bfhi(w.y) * rs * g0[3]}, (f32x4*)o);
        __builtin_nontemporal_store((f32x4){bflo(w.z) * rs * g1[0], bfhi(w.z) * rs * g1[1], bflo(w.w) * rs * g1[2], bfhi(w.w) * rs * g1[3]}, (f32x4*)(o + 4)); }
}
__device__ __forceinline__ float ret_log2g(int h) { return log1pf(-exp2f(-5.f - (float)h)) * 1.4426950408889634f; }
constexpr int VT_LD = 136;
__device__ __forceinline__ void ret_kv_phase(const Frame& F, const bf16* P0, float* KV) {
    LAS bf16* Vt = (LAS bf16*)F.lds; LAS bf16* Kt = Vt + 64 * VT_LD;
    const int fr = F.lane & 15, fq = F.lane >> 4; const int s = F.tid >> 2, part = F.tid & 3;
    v4u pv0, pv1, pk0, pk1;
#define KV_PREFETCH(uu) { const int n_ = (uu) & 31, bh_ = (uu) >> 5, h_ = bh_ & 7, b_ = bh_ >> 3; const bf16* src = P0 + (size_t)(b_ * SEQL + n_ * 128 + s) * 2048 + 64 * h_ + 16 * part; \
        pv0 = *(const v4u*)(src + 1024); pv1 = *(const v4u*)(src + 1032); pk0 = *(const v4u*)(src + 512); pk1 = *(const v4u*)(src + 520); }
    int u = F.bx; if (u < 2048) KV_PREFETCH(u);
    for (; u < 2048; u += F.G) { const int h = (u >> 5) & 7; const float lg = ret_log2g(h);
        __syncthreads();
        { LAS bf16* vd = Vt + (16 * part) * VT_LD + s; LAS bf16* kd = Kt + (16 * part) * VT_LD + s; const float z = exp2f((float)(127 - s) * lg);
#define PUT(k, w) vd[(k) * VT_LD] = (bf16)((w) & 0xffffu); vd[((k) + 1) * VT_LD] = (bf16)((w) >> 16)
#define PUTK(k, w) kd[(k) * VT_LD] = (bf16)f2bf(bflo(w) * z); kd[((k) + 1) * VT_LD] = (bf16)f2bf(bfhi(w) * z)
          PUT(0, pv0.x); PUT(2, pv0.y); PUT(4, pv0.z); PUT(6, pv0.w); PUT(8, pv1.x); PUT(10, pv1.y); PUT(12, pv1.z); PUT(14, pv1.w);
          PUTK(0, pk0.x); PUTK(2, pk0.y); PUTK(4, pk0.z); PUTK(6, pk0.w); PUTK(8, pk1.x); PUTK(10, pk1.y); PUTK(12, pk1.z); PUTK(14, pk1.w);
#undef PUT
#undef PUTK
        }
        __syncthreads();
        if (u + F.G < 2048) KV_PREFETCH(u + F.G);
#pragma unroll
        for (int t2 = 0; t2 < 2; ++t2) { const int id = 2 * F.wave + t2, et = id >> 2, dt = id & 3; pg8::f32x4 acc = {0.f, 0.f, 0.f, 0.f};
#pragma unroll
            for (int sk = 0; sk < 4; ++sk) { const bf16x8 a = *(const LAS bf16x8*)(Vt + (16 * et + fr) * VT_LD + 32 * sk + 8 * fq), bb = *(const LAS bf16x8*)(Kt + (16 * dt + fr) * VT_LD + 32 * sk + 8 * fq);
                acc = __builtin_amdgcn_mfma_f32_16x16x32_bf16(a, bb, acc, 0, 0, 0); }
            float* o = KV + (size_t)u * 4096 + (16 * et + 4 * fq) * 64 + 16 * dt + fr;
#pragma unroll
            for (int j = 0; j < 4; ++j) o[j * 64] = acc[j]; }
    }
#undef KV_PREFETCH
    __syncthreads();
}
__device__ __forceinline__ void ret_scan_phase(const Frame& F, const float* KV, bf16* RT) {
    for (int idx = F.bx * NTHR + F.tid; idx < 64 * 4096; idx += F.G * NTHR) { const int bh = idx >> 12, el = idx & 4095, h = bh & 7; const float cd = exp2f(128.f * ret_log2g(h));
        float r = 0.f; const float* kv = KV + (size_t)bh * 32 * 4096 + el; bf16* rt = RT + (size_t)bh * 32 * 4096 + el; float k[32];
#pragma unroll
        for (int n = 0; n < 32; ++n) k[n] = kv[(size_t)n * 4096];
#pragma unroll
        for (int n = 0; n < 32; ++n) { rt[(size_t)n * 4096] = (bf16)f2bf(r); r = cd * r + k[n]; } }
}
constexpr int QK_LD = 72;
__device__ __forceinline__ void ret_out_phase(const Frame& F, const bf16* P0, const bf16* RT, bf16* MIX) {
    LAS bf16* Vt = (LAS bf16*)F.lds; LAS bf16* Qs = Vt + 64 * VT_LD; LAS bf16* Ks = Qs + 128 * QK_LD; LAS bf16* Rs = Ks + 128 * QK_LD;
    const int fr = F.lane & 15, fq = F.lane >> 4, w = F.wave;
    const int srow0 = F.tid >> 3, sch = F.tid & 7;
    v4u pq[2], pk[2], pv[2], pr;
#define RET_PREFETCH(uu) { const int n_ = (uu) & 31, bh_ = (uu) >> 5, h_ = bh_ & 7, b_ = bh_ >> 3; const bf16* s_ = P0 + (size_t)(b_ * SEQL + n_ * 128 + srow0) * 2048 + 64 * h_ + 8 * sch; \
        pq[0] = *(const v4u*)s_; pk[0] = *(const v4u*)(s_ + 512); pv[0] = *(const v4u*)(s_ + 1024); \
        pq[1] = *(const v4u*)(s_ + 64 * 2048); pk[1] = *(const v4u*)(s_ + 64 * 2048 + 512); pv[1] = *(const v4u*)(s_ + 64 * 2048 + 1024); \
        pr = *(const v4u*)(RT + (size_t)(uu) * 4096 + F.tid * 8); }
    int u = F.bx; if (u < 2048) RET_PREFETCH(u);
    for (; u < 2048; u += F.G) { const int n = u & 31, bh = u >> 5, h = bh & 7, b = bh >> 3; const float lg = ret_log2g(h); const int rowbase = b * SEQL + n * 128;
        __syncthreads();
#pragma unroll
        for (int i = 0; i < 2; ++i) { const int row = srow0 + 64 * i; *(LAS v4u*)(Qs + row * QK_LD + 8 * sch) = pq[i]; *(LAS v4u*)(Ks + row * QK_LD + 8 * sch) = pk[i];
            LAS bf16* vd = Vt + (8 * sch) * VT_LD + row; const v4u v = pv[i];
            vd[0 * VT_LD] = (bf16)(v.x & 0xffffu); vd[1 * VT_LD] = (bf16)(v.x >> 16); vd[2 * VT_LD] = (bf16)(v.y & 0xffffu); vd[3 * VT_LD] = (bf16)(v.y >> 16);
            vd[4 * VT_LD] = (bf16)(v.z & 0xffffu); vd[5 * VT_LD] = (bf16)(v.z >> 16); vd[6 * VT_LD] = (bf16)(v.w & 0xffffu); vd[7 * VT_LD] = (bf16)(v.w >> 16); }
        *(LAS v4u*)(Rs + srow0 * QK_LD + 8 * sch) = pr;
        const int t = 16 * w + fr; v2u gwv[4];
        { const bf16* gp = P0 + (size_t)(rowbase + t) * 2048 + 1536 + 64 * h + 4 * fq;
#pragma unroll
          for (int et = 0; et < 4; ++et) gwv[et] = *(const v2u*)(gp + 16 * et); }
        __syncthreads();
        if (u + F.G < 2048) RET_PREFETCH(u + F.G);
        const bf16x8 q0 = *(const LAS bf16x8*)(Qs + t * QK_LD + 8 * fq), q1 = *(const LAS bf16x8*)(Qs + t * QK_LD + 8 * fq + 32);
        pg8::f32x4 ao[4], ai[4];
#pragma unroll
        for (int et = 0; et < 4; ++et) { ao[et] = (pg8::f32x4){0.f, 0.f, 0.f, 0.f}; ai[et] = (pg8::f32x4){0.f, 0.f, 0.f, 0.f}; }
#pragma unroll
        for (int c32 = 0; c32 < 4; ++c32) { if (c32 <= (w >> 1)) {
            const LAS bf16* kp = Ks + (32 * c32 + fr) * QK_LD + 8 * fq;
            const bf16x8 kA0 = *(const LAS bf16x8*)kp, kA1 = *(const LAS bf16x8*)(kp + 32), kB0 = *(const LAS bf16x8*)(kp + 16 * QK_LD), kB1 = *(const LAS bf16x8*)(kp + 16 * QK_LD + 32);
            pg8::f32x4 s0 = {0.f, 0.f, 0.f, 0.f}, s1 = {0.f, 0.f, 0.f, 0.f};
            s0 = __builtin_amdgcn_mfma_f32_16x16x32_bf16(kA0, q0, s0, 0, 0, 0); s0 = __builtin_amdgcn_mfma_f32_16x16x32_bf16(kA1, q1, s0, 0, 0, 0);
            s1 = __builtin_amdgcn_mfma_f32_16x16x32_bf16(kB0, q0, s1, 0, 0, 0); s1 = __builtin_amdgcn_mfma_f32_16x16x32_bf16(kB1, q1, s1, 0, 0, 0);
            float pvv[8];
#pragma unroll
            for (int j = 0; j < 4; ++j) { const int sA = 32 * c32 + 4 * fq + j, rA = t - sA, rB = rA - 16;
                pvv[j] = rA >= 0 ? s0[j] * exp2f((float)rA * lg) : 0.f; pvv[4 + j] = rB >= 0 ? s1[j] * exp2f((float)rB * lg) : 0.f; }
            v4u pw; pw.x = pk2(pvv[0], pvv[1]); pw.y = pk2(pvv[2], pvv[3]); pw.z = pk2(pvv[4], pvv[5]); pw.w = pk2(pvv[6], pvv[7]);
            const bf16x8 pb = __builtin_bit_cast(bf16x8, pw);
#pragma unroll
            for (int et = 0; et < 4; ++et) { const LAS bf16* vp = Vt + (16 * et + fr) * VT_LD + 32 * c32 + 4 * fq; const v2u lo = *(const LAS v2u*)vp, hi = *(const LAS v2u*)(vp + 16);
                v4u aw; aw.x = lo.x; aw.y = lo.y; aw.z = hi.x; aw.w = hi.y;
                ao[et] = __builtin_amdgcn_mfma_f32_16x16x32_bf16(__builtin_bit_cast(bf16x8, aw), pb, ao[et], 0, 0, 0); }
        } }
#pragma unroll
        for (int et = 0; et < 4; ++et) { const LAS bf16* rp = Rs + (16 * et + fr) * QK_LD + 8 * fq; const bf16x8 r0 = *(const LAS bf16x8*)rp, r1 = *(const LAS bf16x8*)(rp + 32);
            ai[et] = __builtin_amdgcn_mfma_f32_16x16x32_bf16(r0, q0, ai[et], 0, 0, 0); ai[et] = __builtin_amdgcn_mfma_f32_16x16x32_bf16(r1, q1, ai[et], 0, 0, 0); }
        const float xi = exp2f((float)(t + 1) * lg);
        float sum = 0.f;
#pragma unroll
        for (int et = 0; et < 4; ++et) { ao[et] = ao[et] + ai[et] * xi; sum += (ao[et][0] + ao[et][1]) + (ao[et][2] + ao[et][3]); }
        sum += __shfl_xor(sum, 16); sum += __shfl_xor(sum, 32);
        const float mean = sum * (1.f / 64.f); float var = 0.f;
#pragma unroll
        for (int et = 0; et < 4; ++et) { ao[et] = ao[et] - mean; var += (ao[et][0] * ao[et][0] + ao[et][1] * ao[et][1]) + (ao[et][2] * ao[et][2] + ao[et][3] * ao[et][3]); }
        var += __shfl_xor(var, 16); var += __shfl_xor(var, 32);
        const float rstd = 1.f / sqrtf(var * (1.f / 64.f) + EPS);
        bf16* op = MIX + (size_t)(rowbase + t) * DM_ + 64 * h + 4 * fq;
#pragma unroll
        for (int et = 0; et < 4; ++et) { const v2u gw = gwv[et]; const float g0 = bflo(gw.x), g1 = bfhi(gw.x), g2 = bflo(gw.y), g3 = bfhi(gw.y);
            v2u ow; ow.x = pk2(g0 * sigm(g0) * ao[et][0] * rstd, g1 * sigm(g1) * ao[et][1] * rstd); ow.y = pk2(g2 * sigm(g2) * ao[et][2] * rstd, g3 * sigm(g3) * ao[et][3] * rstd);
            *(v2u*)(op + 16 * et) = ow; }
    }
#undef RET_PREFETCH
    __syncthreads();
}

struct S5P { const float *lre, *lim, *bre, *bim, *cre, *cim, *dsk, *lstep; };
__device__ __forceinline__ void s5_coef(float lr, float li, float delta, float& cr, float& ci) {
    float br, bi; cpow(lr, li, delta, 1.f, br, bi); const float a = br - 1.f, den = 1.f / (lr * lr + li * li); cr = (a * lr + bi * li) * den; ci = (bi * lr - a * li) * den;
}
__device__ __forceinline__ void s5_build(const Frame& F, const S5P& P, bf16* W1T, bf16* WYT, float* KMAT) {
    const int it0 = F.gw * 64 + F.lane, NT = F.NGW * 64;
    for (int it = F.gw; it < 32 * 32; it += F.NGW) { const int g = it >> 5, j = it & 31; const float delta = expf(P.lstep[g]);
        const float lr = P.lre[g * 64 + F.lane], li = P.lim[g * 64 + F.lane]; float pr, pi, cr, ci; cpow(lr, li, delta, (float)j, pr, pi); s5_coef(lr, li, delta, cr, ci);
        const float zr = pr * cr - pi * ci, zi = pr * ci + pi * cr; const int cp = F.lane >> 2, c4 = 4 * (F.lane & 3);
        f32x4 acc = {0.f, 0.f, 0.f, 0.f};
#pragma unroll 8
        for (int p = 0; p < 64; ++p) { const float zrp = __shfl(zr, p), zip = __shfl(zi, p); const float c_r = P.cre[(g * 16 + cp) * 64 + p], c_i = P.cim[(g * 16 + cp) * 64 + p];
            const float wr_ = c_r * zrp - c_i * zip, wi_ = c_r * zip + c_i * zrp;
            const f32x4 b_r = *(const f32x4*)(P.bre + (size_t)(g * 64 + p) * 16 + c4), b_i = *(const f32x4*)(P.bim + (size_t)(g * 64 + p) * 16 + c4);
            acc = acc + b_r * wr_ - b_i * wi_; }
        *(f32x4*)(KMAT + ((size_t)((g * 32 + j) * 16 + cp)) * 16 + c4) = acc; }
    for (int it = it0; it < 32 * 64 * 32; it += NT) { const int sg = it & 31, p = (it >> 5) & 63, g = it >> 11; const float delta = expf(P.lstep[g]); const float lr = P.lre[g * 64 + p], li = P.lim[g * 64 + p];
        float pr, pi, cr, ci; cpow(lr, li, delta, (float)(31 - sg), pr, pi); s5_coef(lr, li, delta, cr, ci); const float zr = pr * cr - pi * ci, zi = pr * ci + pi * cr;
        const float* brp = P.bre + (size_t)(g * 64 + p) * 16; const float* bip = P.bim + (size_t)(g * 64 + p) * 16; float re[16], im[16];
#pragma unroll
        for (int c = 0; c < 16; ++c) { re[c] = zr * brp[c] - zi * bip[c]; im[c] = zr * bip[c] + zi * brp[c]; }
        bf16* o = W1T + ((size_t)g * 256 + p) * 512 + sg * 16; bf16* o2 = o + (size_t)64 * 512;
        *(v4u*)o = (v4u){pk2(re[0], re[1]), pk2(re[2], re[3]), pk2(re[4], re[5]), pk2(re[6], re[7])}; *(v4u*)(o + 8) = (v4u){pk2(re[8], re[9]), pk2(re[10], re[11]), pk2(re[12], re[13]), pk2(re[14], re[15])};
        *(v4u*)o2 = (v4u){pk2(im[0], im[1]), pk2(im[2], im[3]), pk2(im[4], im[5]), pk2(im[6], im[7])}; *(v4u*)(o2 + 8) = (v4u){pk2(im[8], im[9]), pk2(im[10], im[11]), pk2(im[12], im[13]), pk2(im[14], im[15])}; }
    for (int it = it0; it < 32 * 128 * 64; it += NT) { const int g = it >> 13, r = it & 8191; *(v4u*)(W1T + ((size_t)g * 256 + 128) * 512 + (size_t)r * 8) = (v4u){0u, 0u, 0u, 0u}; }
    for (int it = it0; it < 32 * 32 * 64; it += NT) { const int p = it & 63, tau = (it >> 6) & 31, g = it >> 11; const float delta = expf(P.lstep[g]); float pr, pi; cpow(P.lre[g * 64 + p], P.lim[g * 64 + p], delta, (float)(tau + 1), pr, pi);
#pragma unroll 4
        for (int cp = 0; cp < 16; ++cp) { const float c_r = P.cre[(g * 16 + cp) * 64 + p], c_i = P.cim[(g * 16 + cp) * 64 + p]; bf16* o = WYT + ((size_t)g * 512 + tau * 16 + cp) * 640 + 512 + p;
            o[0] = (bf16)f2bf(c_r * pr - c_i * pi); o[64] = (bf16)f2bf(-(c_r * pi + c_i * pr)); } }
}
__device__ __forceinline__ void s5_fill_T(const Frame& F, const float* KMAT, bf16* WYT) {
    for (int it = F.bx * NTHR + F.tid; it < 32 * 512 * 64; it += F.G * NTHR) { const int k0 = (it & 63) * 8, n = (it >> 6) & 511, g = it >> 15; const int sg = k0 >> 4, c0 = k0 & 15, tau = n >> 4, cp = n & 15;
        v4u w = {0u, 0u, 0u, 0u};
        if (tau >= sg) { const float* k = KMAT + ((size_t)((g * 32 + (tau - sg)) * 16 + cp)) * 16 + c0; const f32x4 a = *(const f32x4*)k, b = *(const f32x4*)(k + 4); w = (v4u){pk2(a[0], a[1]), pk2(a[2], a[3]), pk2(b[0], b[1]), pk2(b[2], b[3])}; }
        *(v4u*)(WYT + ((size_t)g * 512 + n) * 640 + k0) = w; }
}
__device__ __forceinline__ void s5_scan_phase(const Frame& F, const S5P& P, const float* __restrict__ SLOC, bf16* __restrict__ UX) {
    for (int it = F.gw; it < 256; it += F.NGW) { const int g = it & 31, b = it >> 5, p = F.lane; const float delta = expf(P.lstep[g]); float ar, ai_; cpow(P.lre[g * 64 + p], P.lim[g * 64 + p], delta, 32.f, ar, ai_);
        float xr = 0.f, xi = 0.f; const float* s = SLOC + ((size_t)g * 1024 + b * 128) * 128 + p; bf16* o = UX + ((size_t)g * 1024 + b * 128) * 640 + 512 + p;
        for (int c0 = 0; c0 < 128; c0 += 32) { float sr[32], si[32];
#pragma unroll
            for (int c = 0; c < 32; ++c) { sr[c] = s[(size_t)(c0 + c) * 128]; si[c] = s[(size_t)(c0 + c) * 128 + 64]; }
#pragma unroll
            for (int c = 0; c < 32; ++c) { o[(size_t)(c0 + c) * 640] = (bf16)f2bf(xr); o[(size_t)(c0 + c) * 640 + 64] = (bf16)f2bf(xi);
                const float nr = ar * xr - ai_ * xi + sr[c], ni = ar * xi + ai_ * xr + si[c]; xr = nr; xi = ni; } } }
}

struct Args { const float* in[NIN]; float* out; unsigned char* ws; int ph_lo, ph_hi; };
__device__ __forceinline__ int opq(int k) { asm volatile("" : "+s"(k)); return k; }
__device__ __forceinline__ void prologue_build(const Frame& F, const Args& a) {
    unsigned char* ws = a.ws;
    LAS float* scr = (LAS float*)(F.lds + F.wave * 16384);
    S5P sp{a.in[7], a.in[8], a.in[9], a.in[10], a.in[11], a.in[12], a.in[13], a.in[14]};
    s5_build(F, sp, (bf16*)(ws + WS_W1T), (bf16*)(ws + WS_WYT), (float*)(ws + WS_KMAT));
    if (PROBE_ID == 43) s5_build(F, sp, (bf16*)(ws + WS_W1T), (bf16*)(ws + WS_WYT), (float*)(ws + WS_KMAT));
#define TR_MAT(Wp, Kd, Nd, WTp, mode, lim, HG, gainp) { constexpr int nblk_ = (Nd) / 32, kblk_ = (Kd) / 64, kgr_ = (kblk_ + 7) / 8; if (r < nblk_ * kgr_) { const int nb_ = r % nblk_, kb_ = (r / nblk_) * 8 + F.wave; \
        if (kb_ < kblk_) transpose_item<HG>(Wp, Kd, Nd, WTp, mode, lim, scr, kb_ * nblk_ + nb_, F.lane, gainp); continue; } r -= nblk_ * kgr_; }
    constexpr int WI_A = 80 * 2 + 32 * 2 + 16 * 1 + 96 * 2 + 32 * 2, WI_L = 88 * 2 + 88 * 2 + 32 * 6 + 32 * 1 + 32 * 2;
    for (int rep_ = 0; rep_ < (PROBE_ID == 44 ? 2 : 1); ++rep_)
    for (int wi = F.bx; wi < WI_A + 2 * WI_L; wi += F.G) { int r = wi;
        TR_MAT(a.in[5], 1024, 2560, (bf16*)(ws + WS_WIN), 1, 1024, true, a.in[2])
        TR_MAT(a.in[6], 1024, 1024, (bf16*)(ws + WS_WOUT), 0, 0, false, nullptr)
        TR_MAT(a.in[15], 512, 512, (bf16*)(ws + WS_WGLU), 0, 0, false, nullptr)
        TR_MAT(a.in[16], 1024, 3072, (bf16*)(ws + WS_WQKV), 1, 2048, true, a.in[2] + 1024)
        TR_MAT(a.in[17], 1024, 1024, (bf16*)(ws + WS_WO), 0, 0, false, nullptr)
        const int L = r / WI_L; r -= L * WI_L;
        TR_MAT(a.in[23] + (size_t)L * 1024 * FF, 1024, FF, (bf16*)(ws + WS_WGU + L * SZ_WGU), 2, 0, true, a.in[3] + L * 1024)
        TR_MAT(a.in[24] + (size_t)L * 1024 * FF, 1024, FF, (bf16*)(ws + WS_WGU + L * SZ_WGU), 3, 0, true, a.in[3] + L * 1024)
        TR_MAT(a.in[25] + (size_t)L * FF * 1024, FF, 1024, (bf16*)(ws + WS_WDN + L * SZ_WDN), 0, 0, false, nullptr)
        TR_MAT(a.in[26] + (size_t)L * 256 * 1024, 256, 1024, (bf16*)(ws + WS_WPP + L * SZ_WPP), 0, 0, false, nullptr)
        TR_MAT(a.in[27] + (size_t)L * 1024 * 1024, 1024, 1024, (bf16*)(ws + WS_WPG + L * SZ_WPG), 0, 0, true, a.in[4] + L * 1024)
    }
#undef TR_MAT
    if (F.bx == 0 && F.tid < 128) ((float*)(ws + WS_GN))[F.tid] = a.in[22][F.tid] * (1.f - (0.8f - 0.6f * 0.7408182206817179f));
    { float* cs = (float*)(ws + WS_CS);
      for (int it = F.bx * NTHR + F.tid; it < SEQL * 32; it += F.G * NTHR) { const int i = it & 31, pos = it >> 5; const float inv = exp2f(-(float)i * (13.287712379549449f / 32.f)); float s, c; sincos_rad((float)pos * inv, s, c);
          cs[pos * 64 + i] = c; cs[pos * 64 + 32 + i] = s; } }
}
__device__ __forceinline__ void prologue_stream(const Frame& F, const Args& a) {
    unsigned char* ws = a.ws;
    { const float* p = a.in[1]; bf16* pb = (bf16*)(ws + WS_PB);
      const size_t T_ = (size_t)F.G * NTHR;
      for (size_t it = (size_t)F.bx * NTHR + F.tid; it < (size_t)2 * M * 256 / 8; it += 4 * T_) { f32x4 x0[4], x1[4];
#pragma unroll
          for (int q = 0; q < 4; ++q) { const size_t i2 = it + q * T_; if (i2 < (size_t)2 * M * 256 / 8) { x0[q] = __builtin_nontemporal_load((const f32x4*)(p + i2 * 8)); x1[q] = __builtin_nontemporal_load((const f32x4*)(p + i2 * 8 + 4)); } }
#pragma unroll
          for (int q = 0; q < 4; ++q) { const size_t i2 = it + q * T_; if (i2 < (size_t)2 * M * 256 / 8) *(v4u*)(pb + i2 * 8) = (v4u){pk2(x0[q][0], x0[q][1]), pk2(x0[q][2], x0[q][3]), pk2(x1[q][0], x1[q][1]), pk2(x1[q][2], x1[q][3])}; } } }
    { const float* x = a.in[0]; bf16* hb = (bf16*)(ws + WS_HN); float* ssq = (float*)(ws + WS_SSP);
      for (int m0 = F.gw; m0 < M; m0 += 4 * F.NGW) { f32x4 v[4][4];
#pragma unroll
          for (int q = 0; q < 4; ++q) { const int m = m0 + q * F.NGW; if (m < M) { const f32x4* xr = (const f32x4*)(x + (size_t)m * DM_) + F.lane;
#pragma unroll
              for (int j = 0; j < 4; ++j) v[q][j] = __builtin_nontemporal_load(xr + 64 * j); } }
#pragma unroll
          for (int q = 0; q < 4; ++q) { const int m = m0 + q * F.NGW; if (m < M) { v2u* o8 = (v2u*)(hb + (size_t)m * DM_) + F.lane; float s = 0.f;
#pragma unroll
              for (int j = 0; j < 4; ++j) { const f32x4 t = v[q][j]; s += (t.x * t.x + t.y * t.y) + (t.z * t.z + t.w * t.w); v2u w; w.x = pk2(t.x, t.y); w.y = pk2(t.z, t.w); o8[64 * j] = w; }
              s = wave_sum(s); if (F.lane < 16) ssq[(size_t)m * 16 + F.lane] = F.lane == 0 ? s : 0.f; } } } }
}

constexpr int NPHASE = 17;
__global__ void __launch_bounds__(NTHR, 2) hybrid_fwd(Args args) {
    extern __shared__ __attribute__((aligned(16))) unsigned char lds[];
    cg::grid_group grid = cg::this_grid();
    unsigned char* const ws = args.ws; float* const H = args.out;
    const int lo = args.ph_lo, hi = args.ph_hi;
#ifndef PH_MASK
#define PH_MASK 0xffffffu
#endif
#define IN(k) (lo <= (k) && (k) < hi && ((PH_MASK >> (k)) & 1u))
#define SEAM(k) do { if (IN((k) + 1)) grid.sync(); } while (0)
#define MKF() Frame F; { int t_ = threadIdx.x; asm volatile("" : "+v"(t_)); F.lds = (LAS unsigned char*)lds; F.tid = t_; F.lane = t_ & 63; F.wave = __builtin_amdgcn_readfirstlane(t_ >> 6); \
        F.G = gridDim.x; F.bx = blockIdx.x; F.gw = F.wave * F.G + F.bx; F.NGW = F.G * NWAVES; }
#define INP(k) (args.in[opq(k)])
#define WSB(off) ((bf16*)(ws + (off)))
#define GEMM_STD(Aptr, Bptr, ldk, Ncols, EpiT, Eobj) do { pg8::Gemm g_{(const bf16*)(Aptr), (const bf16*)(Bptr), (ldk), (ldk), (ldk), 0, 0}; pg8::StaticOrder S_; S_.init(M, (Ncols), (int)gridDim.x, (int)blockIdx.x); \
        pg8::gemm_phase<EpiT, pg8::StaticOrder, true, true>((LAS unsigned char*)lds, g_, S_, Eobj); } while (0)

#ifndef PROBE_ID
#define PROBE_ID 0
#endif
#define XCDLOCAL() ((gridDim.x % 8 == 0) ? (int)((blockIdx.x % 8) * (gridDim.x / 8) + blockIdx.x / 8) : (int)blockIdx.x)
#define BODY0 { MKF(); prologue_build(F, args); if (PROBE_ID == 41) prologue_build(F, args); prologue_stream(F, args); if (PROBE_ID == 42) prologue_stream(F, args); }
#define BODY2 { { pg8::Gemm g_{WSB(WS_UX), WSB(WS_W1T), 640, 512, 512, (size_t)1024 * 640, (size_t)256 * 512}; GroupOrder S_{4, 1, 32, (int)gridDim.x, XCDLOCAL()}; EpiSloc E{(float*)(ws + WS_SLOC)}; \
                   pg8::gemm_phase<EpiSloc, GroupOrder, true, true>((LAS unsigned char*)lds, g_, S_, E); } \
                 MKF(); ret_kv_phase(F, WSB(WS_PROJ), (float*)(ws + WS_KV)); }
#define BODY3 { MKF(); S5P sp{INP(7), INP(8), INP(9), INP(10), INP(11), INP(12), INP(13), INP(14)}; \
                 s5_scan_phase(F, sp, (const float*)(ws + WS_SLOC), WSB(WS_UX)); ret_scan_phase(F, (const float*)(ws + WS_KV), WSB(WS_RT)); s5_fill_T(F, (const float*)(ws + WS_KMAT), WSB(WS_WYT)); }
#define BODY4A { pg8::Gemm g_{WSB(WS_UX), WSB(WS_WYT), 640, 640, 640, (size_t)1024 * 640, (size_t)512 * 640}; GroupOrder S_{4, 2, 32, (int)gridDim.x, XCDLOCAL()}; EpiS5Y E{WSB(WS_UX), WSB(WS_Y), INP(13)}; \
                   pg8::gemm_phase<EpiS5Y, GroupOrder, true, true>((LAS unsigned char*)lds, g_, S_, E); }
#define BODY4B { MKF(); ret_out_phase(F, WSB(WS_PROJ), WSB(WS_RT), WSB(WS_MIX)); }
#define BODY4 { BODY4A; if (PROBE_ID == 1041) BODY4A; BODY4B; if (PROBE_ID == 1042) BODY4B; }
#define BODY14 { const int G_ = gridDim.x, bx_ = blockIdx.x; const int vcu = (G_ % 8 == 0) ? (bx_ % 8) * (G_ / 8) + bx_ / 8 : bx_; float lam_; \
                  { int t_ = threadIdx.x; asm volatile("" : "+v"(t_)); const int l_ = t_ & 63; lam_ = expf(wave_sum(INP(18)[l_] * INP(19)[l_])) - expf(wave_sum(INP(20)[l_] * INP(21)[l_])) + (0.8f - 0.6f * 0.7408182206817179f); } \
                  attn_body::attn_phase<8>((char*)lds, (const attn_body::bf16*)(ws + WS_PROJ), (attn_body::bf16*)(ws + WS_HN), (attn_body::bf16*)(ws + WS_PP), (long)M * 1024, lam_, (const float*)(ws + WS_GN), G_, vcu); }
    if (threadIdx.x < 64) ((LAS unsigned*)lds)[(131072 >> 2) + threadIdx.x] = 0u;
    __syncthreads();
    XcdBarrier bar = xcd_barrier_post((unsigned*)(ws + WS_BAR), (volatile LAS unsigned*)((LAS unsigned char*)lds + MISC_OFF));
#undef SEAM
#define SEAM(k) do { if (hi > (k) + 1) { if (lo > hi) grid.sync(); xcd_barrier(bar); } } while (0)
#define SSQ(i) ((float*)(ws + WS_SSP) + (size_t)((i) & 1) * M * 16)
    if (IN(0)) { BODY0; if (PROBE_ID == 4) { BODY0; } SEAM(0); if (PROBE_ID == 6) { for (int r_ = 0; r_ < 20; ++r_) xcd_barrier(bar); } }
#define BODY1 { EpiProj<0> E{WSB(WS_PROJ), (const float*)(ws + WS_CS), WSB(WS_UX), SSQ(0)}; GEMM_STD(WSB(WS_HN), WSB(WS_WIN), 1024, 2560, EpiProj<0>, E); }
    if (IN(1)) { BODY1; if (PROBE_ID == 101) BODY1; SEAM(1); }
    if (IN(2)) { BODY2; if (PROBE_ID == 102) BODY2; SEAM(2); }
    if (IN(3)) { BODY3; if (PROBE_ID == 103) BODY3; SEAM(3); }
    if (IN(4)) { BODY4; if (PROBE_ID == 104) BODY4; SEAM(4); }
    if (IN(5)) { EpiGlu E{WSB(WS_Y), WSB(WS_MIX)}; GEMM_STD(WSB(WS_Y), WSB(WS_WGLU), 512, 512, EpiGlu, E); SEAM(5); }
#define BODY6 { EpiRes<true> E{INP(0), WSB(WS_HN), SSQ(1)}; GEMM_STD(WSB(WS_MIX), WSB(WS_WOUT), 1024, 1024, EpiRes<true>, E); }
    if (IN(6)) { BODY6; if (PROBE_ID == 106) BODY6; SEAM(6); }
#define FFN_PLE(L, pb, si, R, Rn)   \
    if (IN((pb) + 0)) { EpiSwiglu E{WSB(WS_ACT), SSQ(si)}; GEMM_STD(WSB(R), WSB(WS_WGU + (L) * SZ_WGU), 1024, 5632, EpiSwiglu, E); if (PROBE_ID == 5 && (L) == 0) { GEMM_STD(WSB(R), WSB(WS_WGU + (L) * SZ_WGU), 1024, 5632, EpiSwiglu, E); } SEAM((pb) + 0); } \
    if (IN((pb) + 1)) { { EpiRes<false> E{WSB(R), WSB(R), SSQ((si) + 1)}; GEMM_STD(WSB(WS_ACT), WSB(WS_WDN + (L) * SZ_WDN), FF, 1024, EpiRes<false>, E); } \
                        EpiPlain E2{WSB(WS_PP)}; GEMM_STD(WSB(WS_PB) + (size_t)(L) * M * 256, WSB(WS_WPP + (L) * SZ_WPP), opq(256), 1024, EpiPlain, E2); SEAM((pb) + 1); } \
    if (IN((pb) + 2)) { EpiPle E{WSB(WS_PP), WSB(R), SSQ((si) + 1), WSB(Rn), SSQ((si) + 2)}; GEMM_STD(WSB(R), WSB(WS_WPG + (L) * SZ_WPG), 1024, 1024, EpiPle, E); if (PROBE_ID == 109 && (L) == 0) { GEMM_STD(WSB(R), WSB(WS_WPG + (L) * SZ_WPG), 1024, 1024, EpiPle, E); } SEAM((pb) + 2); }
    FFN_PLE(0, 7, 1, WS_HN, WS_MIX)
    if (IN(10)) { EpiProj<1> E{WSB(WS_PROJ), (const float*)(ws + WS_CS), nullptr, SSQ(3)}; GEMM_STD(WSB(WS_MIX), WSB(WS_WQKV), 1024, 3072, EpiProj<1>, E); SEAM(10); }
    if (IN(11)) { BODY14; if (PROBE_ID == 2) { BODY14; } if (hi > 13) xcd_barrier(bar); }
    if (IN(13)) { EpiRes<false> E{WSB(WS_MIX), WSB(WS_MIX), SSQ(4)}; GEMM_STD(WSB(WS_PP), WSB(WS_WO), 1024, 1024, EpiRes<false>, E); SEAM(13); }
    FFN_PLE(1, 14, 4, WS_MIX, WS_HN)
    if (IN(17)) { MKF(); final_norm_phase(F, WSB(WS_HN), SSQ(6), INP(28), H); }
#undef IN
#undef SEAM
#undef GEMM_STD
}

#ifndef MK_PER_PHASE
#define MK_PER_PHASE 0
#endif
extern "C" void kernel_launch(void* const* d_in, const int* in_sizes, int n_in, void* d_out, int out_size, void* d_ws, size_t ws_size, hipStream_t stream) {
    static int grid = 0;
    if (grid == 0) {
        if (n_in != NIN || out_size != M * DM_ || ws_size < WS_END) { fprintf(stderr, "kernel_launch: unexpected problem: n_in %d out %d ws %zu\n", n_in, out_size, ws_size); grid = -1; return; }
        int dev = 0, cus = 0, per_cu = 0;
        hipGetDevice(&dev); hipDeviceGetAttribute(&cus, hipDeviceAttributeMultiprocessorCount, dev);
        if (hipFuncSetAttribute((const void*)hybrid_fwd, hipFuncAttributeMaxDynamicSharedMemorySize, LDS_BYTES) != hipSuccess) { fprintf(stderr, "kernel_launch: hipFuncSetAttribute failed\n"); grid = -1; return; }
        if (hipOccupancyMaxActiveBlocksPerMultiprocessor(&per_cu, (const void*)hybrid_fwd, NTHR, LDS_BYTES) != hipSuccess || per_cu < 1) { fprintf(stderr, "kernel_launch: occupancy query says %d\n", per_cu); per_cu = 1; }
        (void)hipGetLastError();
        grid = cus * 1;
        fprintf(stderr, "kernel_launch: grid %d (cus %d, per_cu %d)\n", grid, cus, per_cu);
    }
    if (grid < 0) return;
    if (hipMemsetAsync((char*)d_ws + WS_CTL, 0, CTL_ZERO_BYTES, stream) != hipSuccess) { fprintf(stderr, "kernel_launch: hipMemsetAsync failed\n"); return; }
    Args a{};
    for (int i = 0; i < NIN; ++i) a.in[i] = (const float*)d_in[i];
    a.out = (float*)d_out; a.ws = (unsigned char*)d_ws;
#if MK_PER_PHASE
    for (int ph = 0; ph <= NPHASE; ++ph) { a.ph_lo = ph; a.ph_hi = ph + 1; hipLaunchKernelGGL(hybrid_fwd, dim3(grid), dim3(NTHR), LDS_BYTES, stream, a); }
#else
    a.ph_lo = 0; a.ph_hi = NPHASE + 1;
    void* kargs[] = {&a};
    hipError_t e = hipLaunchCooperativeKernel((const void*)hybrid_fwd, dim3(grid), dim3(NTHR), kargs, LDS_BYTES, stream);
    if (e != hipSuccess) fprintf(stderr, "kernel_launch: cooperative launch failed: %s (grid %d)\n", hipGetErrorString(e), grid);
#endif
}
```
